# Optimizing an MI355X kernel written in HIP

```python
import functools
import jax, jax.numpy as jnp
from jax import lax
import numpy as np

D_MODEL = 1024
BATCH = 32
SEQ = 256
DEPTH = 2
DEC_BATCH = 4
DEC_SEQ = 4096
PAST_LEN = 512

GRID_W = 64
WIN_ROWS = 8
WIN_COLS = 16
N_HEADS = 8
HEAD_DIM = 64
ATTN_DIM = N_HEADS * HEAD_DIM
POOL_GROUPS = 4
POOL_GROUP_DIM = 64
POOL_DIM = POOL_GROUPS * POOL_GROUP_DIM
POOL_WINDOWS = (2, 4, 8, 16)
CONV_DIM = 256
CONV_WIDTH = 3
N_BRANCH = 3
FFN_DIM = 2816
N_MOD = 9
Q_BLOCK = 128
EPS = 1e-6
IN_OFFSETS = (ATTN_DIM, 2 * ATTN_DIM, 3 * ATTN_DIM,
              3 * ATTN_DIM + POOL_DIM,
              3 * ATTN_DIM + POOL_DIM + CONV_DIM,
              3 * ATTN_DIM + POOL_DIM + 2 * CONV_DIM,
              3 * ATTN_DIM + POOL_DIM + 3 * CONV_DIM)
IN_COLS = IN_OFFSETS[-1] + N_BRANCH * D_MODEL

kernel_name = "hybrid_diffusion_na_pool_conv_step"


def rmsnorm(x, g):
    x32 = x.astype(jnp.float32)
    y = x32 * lax.rsqrt(jnp.mean(x32 * x32, axis=-1, keepdims=True) + EPS)
    return y.astype(x.dtype) * g


def modulate(x, shift, scale):
    return x * (1 + scale) + shift


def adaln(cvec, w_mod, b_mod):
    m = jax.nn.silu(cvec) @ w_mod + b_mod
    return m.reshape(cvec.shape[0], N_MOD, D_MODEL)


def swiglu(h, w_gate, w_up, w_down):
    return (jax.nn.silu(h @ w_gate) * (h @ w_up)) @ w_down


def to_heads(t):
    B, L, _ = t.shape
    return t.reshape(B, L, N_HEADS, HEAD_DIM).transpose(0, 2, 1, 3)


def softmax_f32(s, dtype):
    return jax.nn.softmax(s.astype(jnp.float32), axis=-1).astype(dtype)


def context_attention(q, k, v):
    B, H, L, hd = q.shape
    nb = L // Q_BLOCK
    scale = HEAD_DIM ** -0.5
    qb = q.reshape(B, H, nb, Q_BLOCK, hd).transpose(2, 0, 1, 3, 4)

    def block(qi):
        s = jnp.einsum('bhqd,bhkd->bhqk', qi, k).astype(jnp.float32) * scale
        return jnp.einsum('bhqk,bhkd->bhqd', softmax_f32(s, v.dtype), v)

    o = lax.map(block, qb)
    return o.transpose(1, 2, 0, 3, 4).reshape(B, H, L, hd)


def neighbourhood_attention(q, k, v, k_ctx, v_ctx, rpb):
    B, H, T, hd = q.shape
    rows = T // GRID_W
    win_r = min(WIN_ROWS, rows)
    n_loc = win_r * WIN_COLS
    scale = HEAD_DIM ** -0.5
    kg = k.reshape(B, H, rows, GRID_W, hd)
    vg = v.reshape(B, H, rows, GRID_W, hd)
    q_rows = q.reshape(B, H, rows, GRID_W, hd).transpose(2, 0, 1, 3, 4)
    cols = jnp.arange(GRID_W)
    col_start = jnp.clip(cols - WIN_COLS // 2, 0, GRID_W - WIN_COLS)
    col_idx = col_start[:, None] + jnp.arange(WIN_COLS)[None, :]
    col_off = col_idx - cols[:, None] + (WIN_COLS - 1)
    rpb_cols = rpb[:, :, col_off]

    def row_block(args):
        r, q_r = args
        rs = jnp.clip(r - win_r // 2, 0, rows - win_r)
        kb = lax.dynamic_slice_in_dim(kg, rs, win_r, axis=2)[:, :, :, col_idx]
        vb = lax.dynamic_slice_in_dim(vg, rs, win_r, axis=2)[:, :, :, col_idx]
        row_off = rs + jnp.arange(win_r) - r + (WIN_ROWS - 1)
        bias = rpb_cols[:, row_off].transpose(0, 2, 1, 3).astype(jnp.float32)
        s_loc = jnp.einsum('bhqd,bhrqjd->bhqrj', q_r, kb).astype(jnp.float32) * scale + bias[None]
        s_ctx = jnp.einsum('bhqd,bhkd->bhqk', q_r, k_ctx).astype(jnp.float32) * scale
        s = jnp.concatenate([s_loc.reshape(B, H, GRID_W, n_loc), s_ctx], axis=-1)
        p = softmax_f32(s, v.dtype)
        p_loc = p[..., :n_loc].reshape(B, H, GRID_W, win_r, WIN_COLS)
        return (jnp.einsum('bhqrj,bhrqjd->bhqd', p_loc, vb)
                + jnp.einsum('bhqk,bhkd->bhqd', p[..., n_loc:], v_ctx))

    o = lax.map(row_block, (jnp.arange(rows), q_rows))
    return o.transpose(1, 2, 0, 3, 4).reshape(B, H, T, hd)


def multiscale_pool(u, w_pool, pool_scale):
    B, L, _ = u.shape
    t = jnp.arange(L)
    ug = u.reshape(B, L, POOL_GROUPS, POOL_GROUP_DIM)
    outs = []
    for g, w in enumerate(POOL_WINDOWS):
        x_g = ug[:, :, g].astype(jnp.float32)
        cs = jnp.concatenate([jnp.zeros((B, 1, POOL_GROUP_DIM), jnp.float32),
                              jnp.cumsum(x_g, axis=1)], axis=1)
        lo = jnp.clip(t - w // 2, 0, L)
        hi = jnp.clip(t - w // 2 + w, 0, L)
        mean = (jnp.take(cs, hi, axis=1) - jnp.take(cs, lo, axis=1)) / (hi - lo).astype(jnp.float32)[None, :, None]
        outs.append((mean - x_g).astype(u.dtype))
    d = jnp.stack(outs, axis=2)
    y = jnp.einsum('blgc,gcd->blgd', d, w_pool).reshape(B, L, POOL_DIM)
    return y * pool_scale


def short_conv(z, w_conv, b_conv):
    y = lax.conv_general_dilated(z, w_conv[:, None, :], window_strides=(1,),
                                 padding=((CONV_WIDTH // 2, CONV_WIDTH // 2),),
                                 dimension_numbers=('NWC', 'WIO', 'NWC'),
                                 feature_group_count=CONV_DIM)
    return y + b_conv


def trunk_layer(x, mod, lp, attend):
    m = [mod[:, i, None, :] for i in range(N_MOD)]
    B, L, _ = x.shape
    h = modulate(rmsnorm(x, lp['g_ffn1']), m[0], m[1])
    x = x + 0.5 * m[2] * swiglu(h, lp['w_ffn1_gate'], lp['w_ffn1_up'], lp['w_ffn1_down'])
    n = modulate(rmsnorm(x, lp['g_mix']), m[3], m[4])
    proj = n @ lp['w_in']
    q, k, v, u_pool, u_conv, gate_b, gate_c, merge = jnp.split(proj, IN_OFFSETS, axis=-1)
    q = rmsnorm(to_heads(q), lp['g_q'])
    k = rmsnorm(to_heads(k), lp['g_k'])
    v = to_heads(v)
    a = attend(q, k, v).transpose(0, 2, 1, 3).reshape(B, L, ATTN_DIM)
    pl = multiscale_pool(u_pool, lp['w_pool'], lp['pool_scale'])
    cv = gate_b * short_conv(gate_c * u_conv, lp['w_conv'], lp['b_conv'])
    g_a, g_p, g_c = jnp.split(jax.nn.sigmoid(merge), N_BRANCH, axis=-1)
    merged = (g_a * (a @ lp['w_br_attn']) + g_p * (pl @ lp['w_br_pool'])
              + g_c * (cv @ lp['w_br_conv']))
    x = x + m[5] * (merged @ lp['w_out'])
    h = modulate(rmsnorm(x, lp['g_ffn2']), m[6], m[7])
    x = x + 0.5 * m[8] * swiglu(h, lp['w_ffn2_gate'], lp['w_ffn2_up'], lp['w_ffn2_down'])
    return x, k, v


def setup_inputs(seed: int = 0) -> dict:
    key = jax.random.key(seed)
    ks = iter(jax.random.split(key, 40))
    f32 = jnp.float32

    def nrm(shape, s=1.0):
        return jax.random.normal(next(ks), shape, f32) * s

    def gain(shape):
        return 1.0 + nrm(shape, 0.05)

    D = D_MODEL
    return {
        'x_prompt': nrm((BATCH, SEQ, D)),
        'x_sample': nrm((DEC_BATCH, DEC_SEQ, D)),
        'cache_k': nrm((DEC_BATCH, DEPTH, N_HEADS, PAST_LEN, HEAD_DIM)),
        'cache_v': nrm((DEC_BATCH, DEPTH, N_HEADS, PAST_LEN, HEAD_DIM)),
        'c': nrm((DEC_BATCH, D)),
        'c_ctx': nrm((D,)),
        'w_mod': nrm((DEPTH, D, N_MOD * D), 0.5 * D ** -0.5),
        'b_mod': nrm((DEPTH, N_MOD * D), 0.02),
        'g_ffn1': gain((DEPTH, D)),
        'w_ffn1_gate': nrm((DEPTH, D, FFN_DIM), D ** -0.5),
        'w_ffn1_up': nrm((DEPTH, D, FFN_DIM), D ** -0.5),
        'w_ffn1_down': nrm((DEPTH, FFN_DIM, D), FFN_DIM ** -0.5),
        'g_mix': gain((DEPTH, D)),
        'w_in': nrm((DEPTH, D, IN_COLS), D ** -0.5),
        'g_q': gain((DEPTH, HEAD_DIM)),
        'g_k': gain((DEPTH, HEAD_DIM)),
        'rpb': nrm((DEPTH, N_HEADS, 2 * WIN_ROWS - 1, 2 * WIN_COLS - 1), 0.5),
        'w_pool': nrm((DEPTH, POOL_GROUPS, POOL_GROUP_DIM, POOL_GROUP_DIM), POOL_GROUP_DIM ** -0.5),
        'pool_scale': 1.0 + nrm((DEPTH, POOL_DIM), 0.1),
        'w_conv': nrm((DEPTH, CONV_WIDTH, CONV_DIM), CONV_WIDTH ** -0.5),
        'b_conv': nrm((DEPTH, CONV_DIM), 0.02),
        'w_br_attn': nrm((DEPTH, ATTN_DIM, D), ATTN_DIM ** -0.5),
        'w_br_pool': nrm((DEPTH, POOL_DIM, D), POOL_DIM ** -0.5),
        'w_br_conv': nrm((DEPTH, CONV_DIM, D), CONV_DIM ** -0.5),
        'w_out': nrm((DEPTH, D, D), D ** -0.5),
        'g_ffn2': gain((DEPTH, D)),
        'w_ffn2_gate': nrm((DEPTH, D, FFN_DIM), D ** -0.5),
        'w_ffn2_up': nrm((DEPTH, D, FFN_DIM), D ** -0.5),
        'w_ffn2_down': nrm((DEPTH, FFN_DIM, D), FFN_DIM ** -0.5),
    }


def reference(x_prompt, x_sample, cache_k, cache_v, c, c_ctx, w_mod, b_mod,
              g_ffn1, w_ffn1_gate, w_ffn1_up, w_ffn1_down, g_mix, w_in, g_q, g_k, rpb,
              w_pool, pool_scale, w_conv, b_conv, w_br_attn, w_br_pool, w_br_conv, w_out,
              g_ffn2, w_ffn2_gate, w_ffn2_up, w_ffn2_down):
    xp = x_prompt
    xs = x_sample
    new_k = []
    new_v = []
    for l in range(DEPTH):
        lp = {
            'g_ffn1': g_ffn1[l], 'w_ffn1_gate': w_ffn1_gate[l], 'w_ffn1_up': w_ffn1_up[l],
            'w_ffn1_down': w_ffn1_down[l], 'g_mix': g_mix[l], 'w_in': w_in[l],
            'g_q': g_q[l], 'g_k': g_k[l], 'w_pool': w_pool[l], 'pool_scale': pool_scale[l],
            'w_conv': w_conv[l], 'b_conv': b_conv[l], 'w_br_attn': w_br_attn[l],
            'w_br_pool': w_br_pool[l], 'w_br_conv': w_br_conv[l], 'w_out': w_out[l],
            'g_ffn2': g_ffn2[l], 'w_ffn2_gate': w_ffn2_gate[l], 'w_ffn2_up': w_ffn2_up[l],
            'w_ffn2_down': w_ffn2_down[l],
        }
        mod_ctx = adaln(c_ctx[None, :], w_mod[l], b_mod[l])
        xp, kp, vp = trunk_layer(xp, mod_ctx, lp, context_attention)
        new_k.append(kp)
        new_v.append(vp)
        mod_lat = adaln(c, w_mod[l], b_mod[l])
        attend_lat = functools.partial(neighbourhood_attention, k_ctx=cache_k[:, l],
                                       v_ctx=cache_v[:, l], rpb=rpb[l])
        xs, _, _ = trunk_layer(xs, mod_lat, lp, attend_lat)
    return (xp, xs, jnp.stack(new_k, axis=1), jnp.stack(new_v, axis=1))
```

```cpp
#include <hip/hip_runtime.h>
#include <hip/hip_cooperative_groups.h>
#include <cstdio>
namespace cg = cooperative_groups;

#define LAS __attribute__((address_space(3)))
#define DI __device__ __forceinline__
typedef unsigned short bf16_t;
typedef short bf16x8 __attribute__((ext_vector_type(8)));
typedef short s16x4 __attribute__((ext_vector_type(4)));
typedef float f32x2 __attribute__((ext_vector_type(2)));
typedef float f32x4 __attribute__((ext_vector_type(4)));
typedef float f32x16 __attribute__((ext_vector_type(16)));
typedef unsigned u32x2 __attribute__((ext_vector_type(2)));
typedef unsigned u32x4 __attribute__((ext_vector_type(4)));
typedef __bf16 bf2_t __attribute__((ext_vector_type(2)));

constexpr int DM = 1024, TC = 8192, TL = 16384, TT = TC + TL, FF = 2816, INC = 5632, NMOD = 9;
constexpr int NPH = 23;
#ifndef PHI
#define PHI NPH
#endif
#ifndef REPMASK
#define REPMASK 0
#endif
constexpr size_t OUT_NEWK = 25165824, OUT_NEWV = 33554432;
constexpr size_t WS_MOD = 0;
constexpr size_t WS_CK = 368640;
constexpr size_t WS_CVT = WS_CK + 4194304;
constexpr size_t WS_WB = WS_CVT + 4194304;
constexpr size_t WB_GU1 = 0, WB_D1 = WB_GU1 + 11534336, WB_IN = WB_D1 + 5767168, WB_BR = WB_IN + 11534336, WB_OUT = WB_BR + 2097152,
                 WB_GU2 = WB_OUT + 2097152, WB_D2 = WB_GU2 + 11534336, WB_END = WB_D2 + 5767168;
constexpr size_t WS_HB = WS_WB + WB_END;
constexpr size_t WS_R = WS_HB + 50331648;
constexpr size_t R_Q = 0, R_K = 25165824, R_VT = 50331648, R_MISC = 75497472, R_GATES = 125829120, R_END = 276824064;
constexpr size_t WS_BAR = WS_R + R_END;
constexpr size_t WS_END = WS_BAR + 16384;
constexpr int LDS_BYTES = 131072 + 512 + 8 * 2048;

DI unsigned pk(float a, float b) { f32x2 v = {a, b}; bf2_t r = __builtin_convertvector(v, bf2_t); return __builtin_bit_cast(unsigned, r); }
DI float bflo(unsigned w) { return __uint_as_float(w << 16); }
DI float bfhi(unsigned w) { return __uint_as_float(w & 0xffff0000u); }
DI float xhalf_max(float x) { const unsigned u = __float_as_uint(x); const auto r = __builtin_amdgcn_permlane32_swap(u, u, false, false); return fmaxf(__uint_as_float(r[0]), __uint_as_float(r[1])); }
DI float xhalf_sum(float x) { const unsigned u = __float_as_uint(x); const auto r = __builtin_amdgcn_permlane32_swap(u, u, false, false); return __uint_as_float(r[0]) + __uint_as_float(r[1]); }
DI float sigm(float x) { return __builtin_amdgcn_rcpf(1.0f + __expf(-x)); }
DI float silu(float x) { return x * sigm(x); }
extern __shared__ __attribute__((aligned(16))) unsigned char shm[];
DI unsigned long long ldq(int i) { const unsigned long long v = ((volatile LAS unsigned long long*)((LAS unsigned char*)shm + 131072))[i];
    const unsigned hi = (unsigned)__builtin_amdgcn_readfirstlane((int)(unsigned)(v >> 32)), lo = (unsigned)__builtin_amdgcn_readfirstlane((int)(unsigned)v);
    return ((unsigned long long)hi << 32) | (unsigned long long)lo; }
template <class T> DI T* gptr(unsigned long long v) { typedef __attribute__((address_space(1))) T GT; GT* g = (GT*)v; return (T*)g; }
#define IN(i) (gptr<const float>(ldq(i)))
#define OUTP (gptr<float>(ldq(29)))
#define WSP (gptr<unsigned char>(ldq(30)))
DI int otid() { int t = threadIdx.x; asm volatile("" : "+v"(t)); return t; }

constexpr int HTB = 128 * 64 * 2;
DI int lds_byte(int r, int c) { const int st = (r >> 4) * 2 + (c >> 5), rr = r & 15, cc = c & 31, ob = rr * 64 + cc * 2; return st * 1024 + (ob ^ (((ob >> 9) & 1) << 5)); }
DI void stage_rc(int b, int& R, int& C) { const int st = b / 1024, sb = b % 1024, swz = sb ^ (((sb >> 9) & 1) << 5); R = (st >> 1) * 16 + swz / 64; C = (st & 1) * 32 + (swz % 64) / 2; }
DI int perm32(int rho) { const int n = rho >> 4, i = rho & 15; return 8 * (i >> 2) + 4 * n + (i & 3); }

struct Unit { int pm, pn, koff, nt, mode, amask; };
struct Gemm { const bf16_t* A; const bf16_t* Bt; int lda, ldb; size_t ksa, ksb; };
struct Order {
    int nM, nN, nwg, G, c, nsub, ntk;
    DI void init(int nM_, int nN_, int ntk_, int nsub_) { nM = nM_; nN = nN_; nwg = nM * nN; G = (int)gridDim.x; c = (int)blockIdx.x; nsub = nsub_; ntk = ntk_; }
    DI bool next(int i, Unit& u) const {
        int ii = i, s = 0; if (nsub == 3) { ii = i / 3; s = i - 3 * ii; }
        int wgid; u.amask = 3;
        if (G == 256 && nwg == 384) {
            if (ii == 0) wgid = 32 * (c & 7) + (c >> 3);
            else if (ii == 1) { wgid = 256 + 16 * (c & 7) + (c >> 4); u.amask = 1 << ((c >> 3) & 1); }
            else return false;
        } else {
            long L = (long)ii * G + c;
            if (G == 256 && (nwg & 7) == 0) {
                const int nfull = nwg >> 8;
                if (ii > nfull) return false;
                if (ii == nfull) { const int idx = ((c >> 4) << 3) + (c & 7); if (idx >= nwg - (nfull << 8)) return false; L = (nfull << 8) + idx; u.amask = 1 << ((c >> 3) & 1); }
            }
            if (L >= nwg) return false;
            wgid = (int)L; { const int q = nwg / 8, r = nwg % 8, xcd = wgid % 8, off = wgid / 8; wgid = (xcd < r ? xcd * (q + 1) : r * (q + 1) + (xcd - r) * q) + off; }
        }
        const int nig = 8 * nN, gid = wgid / nig, fm = gid * 8, gsz = (nM - fm) < 8 ? (nM - fm) : 8;
        u.pm = fm + ((wgid % nig) % gsz); u.pn = (wgid % nig) / gsz;
        if (nsub == 3) { u.mode = s; u.koff = s == 0 ? 0 : (s == 1 ? 512 : 768); u.nt = s == 0 ? 8 : 4; }
        else { u.mode = 0; u.koff = 0; u.nt = ntk; }
        return true;
    }
};

template <class Epi>
DI void gemm_phase(LAS unsigned char* lds, const Gemm g, const Order& S, const Epi& E) {
    const int tid = otid(), wid = __builtin_amdgcn_readfirstlane(tid >> 6), lane = tid & 63, wr = wid >> 2, wc = wid & 3, fr = lane & 15, fq = lane >> 4;
    unsigned voffA[2], voffB[2];
#pragma unroll
    for (int i = 0; i < 2; ++i) { int R, C; stage_rc(tid * 16 + i * 8192, R, C); const int Rb = Epi::PERM ? ((R & ~31) + perm32(R & 31)) : R;
        voffA[i] = (unsigned)(R * g.lda + C) * 2u; voffB[i] = (unsigned)(Rb * g.ldb + C) * 2u; }
    const size_t kstepA = g.ksa, kstepB = g.ksb;
    const size_t hstepA = (size_t)128 * g.lda * 2, hstepB = (size_t)128 * g.ldb * 2;
    const unsigned ldsw = (unsigned)wid * 1024u;
    const int aoff = lds_byte(wr * 64 + fr, fq * 8), boff = lds_byte(wc * 32 + fr, fq * 8);
#define PG8_SA(b, h) (((b) * 2 + (h)) * HTB)
#define PG8_SB(b, h) ((4 + (b) * 2 + (h)) * HTB)
#define PG8_STAGE(bufoff, gbase, voff) do { _Pragma("unroll") for (int _i = 0; _i < 2; ++_i) \
        __builtin_amdgcn_global_load_lds((const unsigned*)((const char*)(gbase) + (voff)[_i]), (LAS unsigned*)(lds + (bufoff) + ldsw + _i * 8192), 16, 0, 0); } while (0)
#define PG8_LDA(dst, b, h) do { _Pragma("unroll") for (int m = 0; m < 4; ++m) _Pragma("unroll") for (int k = 0; k < 2; ++k) dst[m][k] = *(const LAS bf16x8*)(lds + PG8_SA(b, h) + aoff + m * 2048 + k * 1024); } while (0)
#define PG8_LDB(dst, b, h) do { _Pragma("unroll") for (int n = 0; n < 2; ++n) _Pragma("unroll") for (int k = 0; k < 2; ++k) dst[n][k] = *(const LAS bf16x8*)(lds + PG8_SB(b, h) + boff + n * 2048 + k * 1024); } while (0)
#define PG8_MMA(ai, bj, At, Bt) do { if (cur.amask & (1 << (ai))) { __builtin_amdgcn_s_setprio(1); _Pragma("unroll") for (int m = 0; m < 4; ++m) _Pragma("unroll") for (int n = 0; n < 2; ++n) _Pragma("unroll") for (int k = 0; k < 2; ++k) \
        acc[ai][bj][m][n] = __builtin_amdgcn_mfma_f32_16x16x32_bf16(Bt[n][k], At[m][k], acc[ai][bj][m][n], 0, 0, 0); __builtin_amdgcn_s_setprio(0); } } while (0)
#define PG8_WAIT_V(n) asm volatile("s_waitcnt vmcnt(" #n ")" ::: "memory")
#define PG8_WAIT_L(n) asm volatile("s_waitcnt lgkmcnt(" #n ")" ::: "memory")
#define PG8_BAR __builtin_amdgcn_s_barrier()
#define PG8_SCHED __builtin_amdgcn_sched_barrier(0)
    Unit cur, nxt; int ui = 0;
    if (!S.next(0, cur)) return;
    f32x4 acc[2][2][4][2];
#pragma unroll
    for (int a = 0; a < 2; ++a)
#pragma unroll
        for (int b = 0; b < 2; ++b)
#pragma unroll
            for (int m = 0; m < 4; ++m)
#pragma unroll
                for (int n = 0; n < 2; ++n) acc[a][b][m][n] = (f32x4){0.f, 0.f, 0.f, 0.f};
    bf16x8 At[4][2], B0[2][2], B1[2][2];
    const char* cA = (const char*)g.A + ((size_t)cur.pm * 256 * g.lda + cur.koff) * 2; const char* cB = (const char*)g.Bt + ((size_t)cur.pn * 256 * g.ldb + cur.koff) * 2;
    PG8_STAGE(PG8_SB(0, 0), cB, voffB); PG8_STAGE(PG8_SA(0, 0), cA, voffA); PG8_STAGE(PG8_SB(0, 1), cB + hstepB, voffB); PG8_STAGE(PG8_SA(0, 1), cA + hstepA, voffA);
    if (wr == 1) PG8_BAR;
    PG8_WAIT_V(4); PG8_BAR;
    PG8_STAGE(PG8_SB(1, 0), cB + kstepB, voffB); PG8_STAGE(PG8_SA(1, 0), cA + kstepA, voffA); PG8_STAGE(PG8_SB(1, 1), cB + hstepB + kstepB, voffB);
    PG8_WAIT_V(6); PG8_BAR;
    for (;;) {
        const bool has_next = S.next(ui + 1, nxt);
        const char* nA = has_next ? (const char*)g.A + ((size_t)nxt.pm * 256 * g.lda + nxt.koff) * 2 : cA;
        const char* nB = has_next ? (const char*)g.Bt + ((size_t)nxt.pn * 256 * g.ldb + nxt.koff) * 2 : cB;
        const int nt = cur.nt;
        for (int t = 0; t < nt; t += 2) {
            const bool last = (t == nt - 2);
            const char* a1 = cA + (size_t)(t + 1) * kstepA;
            const char* a2 = last ? nA : cA + (size_t)(t + 2) * kstepA; const char* b2 = last ? nB : cB + (size_t)(t + 2) * kstepB;
            const char* a3 = a2 + kstepA; const char* b3 = b2 + kstepB;
            PG8_LDB(B0, 0, 0); PG8_SCHED; PG8_LDA(At, 0, 0); PG8_STAGE(PG8_SA(1, 1), a1 + hstepA, voffA);
            PG8_WAIT_L(8); PG8_BAR; PG8_WAIT_L(0); PG8_MMA(0, 0, At, B0); PG8_BAR; PG8_SCHED;
            PG8_LDB(B1, 0, 1); PG8_STAGE(PG8_SB(0, 0), b2, voffB);
            PG8_BAR; PG8_WAIT_L(0); PG8_MMA(0, 1, At, B1); PG8_BAR;
            PG8_LDA(At, 0, 1); PG8_STAGE(PG8_SA(0, 0), a2, voffA);
            PG8_BAR; PG8_WAIT_L(0); PG8_MMA(1, 0, At, B0); PG8_BAR; PG8_SCHED;
            PG8_STAGE(PG8_SB(0, 1), b2 + hstepB, voffB);
            PG8_WAIT_V(6); PG8_BAR; PG8_MMA(1, 1, At, B1); PG8_BAR;
            PG8_LDB(B0, 1, 0); PG8_SCHED; PG8_LDA(At, 1, 0); PG8_STAGE(PG8_SA(0, 1), a2 + hstepA, voffA);
            PG8_WAIT_L(8); PG8_BAR; PG8_WAIT_L(0); PG8_MMA(0, 0, At, B0); PG8_BAR; PG8_SCHED;
            PG8_LDB(B1, 1, 1); PG8_STAGE(PG8_SB(1, 0), b3, voffB);
            PG8_BAR; PG8_WAIT_L(0); PG8_MMA(0, 1, At, B1); PG8_BAR;
            PG8_LDA(At, 1, 1); PG8_STAGE(PG8_SA(1, 0), a3, voffA);
            PG8_BAR; PG8_WAIT_L(0); PG8_MMA(1, 0, At, B0); PG8_BAR; PG8_SCHED;
            PG8_STAGE(PG8_SB(1, 1), b3 + hstepB, voffB);
            PG8_WAIT_V(6); PG8_BAR; PG8_MMA(1, 1, At, B1); PG8_BAR;
        }
        { int fr2 = fr, fq2 = fq; asm volatile("" : "+v"(fr2), "+v"(fq2)); E(acc, cur, wr, wc, fr2, fq2); }
        if (!has_next) break;
        if (!(Epi::CHAIN && cur.mode < 2))
#pragma unroll
        for (int a = 0; a < 2; ++a)
#pragma unroll
            for (int b = 0; b < 2; ++b)
#pragma unroll
                for (int m = 0; m < 4; ++m)
#pragma unroll
                    for (int n = 0; n < 2; ++n) acc[a][b][m][n] = (f32x4){0.f, 0.f, 0.f, 0.f};
        cur = nxt; cA = nA; cB = nB; ++ui;
    }
    PG8_WAIT_V(0);
    if (wr == 0) PG8_BAR;
    PG8_BAR;
#undef PG8_SA
#undef PG8_SB
#undef PG8_STAGE
#undef PG8_LDA
#undef PG8_LDB
#undef PG8_MMA
#undef PG8_WAIT_V
#undef PG8_WAIT_L
#undef PG8_BAR
#undef PG8_SCHED
}

struct EpiSwiGLU {
    static constexpr bool PERM = true, CHAIN = false;
    bf16_t* O;
    DI void operator()(const f32x4 (&acc)[2][2][4][2], const Unit& u, int wr, int wc, int fr, int fq) const {
        const int row0 = u.pm * 256 + wr * 64 + fr, col0 = u.pn * 128 + wc * 32 + 8 * fq;
#pragma unroll
        for (int ai = 0; ai < 2; ++ai)
            if (u.amask & (1 << ai))
#pragma unroll
            for (int m = 0; m < 4; ++m) {
                const f32x4 g0 = acc[ai][0][m][0], g1 = acc[ai][0][m][1], u0 = acc[ai][1][m][0], u1 = acc[ai][1][m][1];
                u32x4 w;
                w.x = pk(silu(g0[0]) * u0[0], silu(g0[1]) * u0[1]); w.y = pk(silu(g0[2]) * u0[2], silu(g0[3]) * u0[3]);
                w.z = pk(silu(g1[0]) * u1[0], silu(g1[1]) * u1[1]); w.w = pk(silu(g1[2]) * u1[2], silu(g1[3]) * u1[3]);
                *(u32x4*)(O + ((size_t)(col0 >> 6) * TT + (row0 + ai * 128 + m * 16)) * 64 + (col0 & 63)) = w;
                if (m & 1) __builtin_amdgcn_sched_barrier(0);
            }
    }
};
struct EpiResid {
    static constexpr bool PERM = false, CHAIN = false;
    const float* xin_c; const float* xin_l; float* xout; const float* mod; int gidx; float gs;
    DI void operator()(const f32x4 (&acc)[2][2][4][2], const Unit& u, int wr, int wc, int fr, int fq) const {
        const int bi = u.pm < 32 ? 0 : 1 + ((u.pm - 32) >> 4);
        const float* mg = mod + (bi * NMOD + gidx) * DM;
        const int r0 = wr * 64 + fr, col0 = u.pn * 256 + wc * 32 + 4 * fq;
        const float* xi = (u.pm < 32 ? xin_c + (size_t)u.pm * 256 * DM : xin_l + (size_t)(u.pm - 32) * 256 * DM) + (size_t)r0 * DM + col0;
        float* xo = xout + (size_t)u.pm * 256 * DM + (size_t)r0 * DM + col0;
        f32x4 gv[2][2];
#pragma unroll
        for (int bj = 0; bj < 2; ++bj)
#pragma unroll
            for (int n = 0; n < 2; ++n) gv[bj][n] = *(const f32x4*)(mg + col0 + bj * 128 + n * 16) * gs;
        f32x4 xa[2][2], xb[2][2];
#define RESID_LD(dst, it) do { const size_t ro_ = (size_t)(((it) >> 2) * 128 + ((it) & 3) * 16) * DM; _Pragma("unroll") for (int bj = 0; bj < 2; ++bj) _Pragma("unroll") for (int n = 0; n < 2; ++n) dst[bj][n] = *(const f32x4*)(xi + ro_ + bj * 128 + n * 16); } while (0)
#define RESID_ST(src, it) do { const size_t ro_ = (size_t)(((it) >> 2) * 128 + ((it) & 3) * 16) * DM; _Pragma("unroll") for (int bj = 0; bj < 2; ++bj) _Pragma("unroll") for (int n = 0; n < 2; ++n) *(f32x4*)(xo + ro_ + bj * 128 + n * 16) = src[bj][n] + gv[bj][n] * acc[(it) >> 2][bj][(it) & 3][n]; } while (0)
#pragma unroll
        for (int ai = 0; ai < 2; ++ai)
            if (u.amask & (1 << ai)) {
                RESID_LD(xa, ai * 4);
#pragma unroll
                for (int it = ai * 4; it < ai * 4 + 4; it += 2) {
                    RESID_LD(xb, it + 1);
                    RESID_ST(xa, it);
                    __builtin_amdgcn_sched_barrier(0);
                    if (it + 2 < ai * 4 + 4) RESID_LD(xa, it + 2);
                    RESID_ST(xb, it + 1);
                    __builtin_amdgcn_sched_barrier(0);
                }
            }
#undef RESID_LD
#undef RESID_ST
    }
};
struct EpiIn {
    static constexpr bool PERM = true, CHAIN = false;
    bf16_t *qb, *kb, *vtc, *vtl, *misc, *gates; float *newk, *newv; const float *gq, *gk; int l;
    DI void operator()(const f32x4 (&acc)[2][2][4][2], const Unit& u, int wr, int wc, int fr, int fq) const {
        const int pn = u.pn, rt0 = wr * 64 + fr;
        if (pn < 4) {
            const bool isk = pn >= 2; const int hh = 4 * (pn & 1) + wc; const float* g = isk ? gk : gq; bf16_t* dst = isk ? kb : qb;
            f32x4 gg[2][2];
#pragma unroll
            for (int bj = 0; bj < 2; ++bj)
#pragma unroll
                for (int n = 0; n < 2; ++n) gg[bj][n] = *(const f32x4*)(g + 32 * bj + 8 * fq + 4 * n);
#pragma unroll
            for (int ai = 0; ai < 2; ++ai)
                if (u.amask & (1 << ai))
#pragma unroll
                for (int m = 0; m < 4; ++m) {
                    float ss = 0.f;
#pragma unroll
                    for (int bj = 0; bj < 2; ++bj)
#pragma unroll
                        for (int n = 0; n < 2; ++n) { const f32x4 v = acc[ai][bj][m][n]; ss += (v[0] * v[0] + v[1] * v[1]) + (v[2] * v[2] + v[3] * v[3]); }
                    ss += __shfl_xor(ss, 16); ss += __shfl_xor(ss, 32);
                    const float r = rsqrtf(ss * (1.0f / 64.0f) + 1e-6f) * (isk ? 1.0f : 0.18033688011112042f);
                    const int rt = rt0 + ai * 128 + m * 16; const size_t row = (size_t)u.pm * 256 + rt;
#pragma unroll
                    for (int bj = 0; bj < 2; ++bj) {
                        const f32x4 y0 = acc[ai][bj][m][0] * r * gg[bj][0], y1 = acc[ai][bj][m][1] * r * gg[bj][1];
                        u32x4 w; w.x = pk(y0[0], y0[1]); w.y = pk(y0[2], y0[3]); w.z = pk(y1[0], y1[1]); w.w = pk(y1[2], y1[3]);
                        if (isk) { const int d0 = 32 * bj + 8 * fq; *(u32x4*)(dst + ((row >> 5) * 8 + hh) * 2048 + (((d0 >> 4) * 2 + ((d0 >> 3) & 1)) * 32 + (row & 31)) * 8) = w; }
                        else *(u32x4*)(dst + row * 512 + hh * 64 + 32 * bj + 8 * fq) = w;
                        if (isk && u.pm < 32) { float* nk = newk + ((((size_t)u.pm * 2 + l) * 8 + hh) * 256 + rt) * 64 + 32 * bj + 8 * fq; *(f32x4*)nk = y0; *(f32x4*)(nk + 4) = y1; }
                    }
                    __builtin_amdgcn_sched_barrier(0);
                }
        } else if (pn < 6) {
            const int hh = 4 * (pn - 4) + wc;
#pragma unroll
            for (int ai = 0; ai < 2; ++ai)
                if (u.amask & (1 << ai))
#pragma unroll
                for (int m = 0; m < 4; ++m) {
                    const int rt = rt0 + ai * 128 + m * 16; const size_t row = (size_t)u.pm * 256 + rt;
                    LAS bf16_t* T = (LAS bf16_t*)((LAS unsigned char*)shm + 131584 + (wr * 4 + wc) * 2048);
                    const int pos = ((fr >> 2) & 1) * 8 + (fr >> 3) * 4 + (fr & 3);
#pragma unroll
                    for (int bj = 0; bj < 2; ++bj) {
                        const f32x4 y0 = acc[ai][bj][m][0], y1 = acc[ai][bj][m][1];
                        const int d0 = 32 * bj + 8 * fq;
                        LAS bf16_t* p = T + d0 * 16 + pos;
                        const unsigned w0 = pk(y0[0], y0[1]), w1 = pk(y0[2], y0[3]), w2 = pk(y1[0], y1[1]), w3 = pk(y1[2], y1[3]);
                        p[0] = (bf16_t)w0; p[16] = (bf16_t)(w0 >> 16); p[32] = (bf16_t)w1; p[48] = (bf16_t)(w1 >> 16);
                        p[64] = (bf16_t)w2; p[80] = (bf16_t)(w2 >> 16); p[96] = (bf16_t)w3; p[112] = (bf16_t)(w3 >> 16);
                        if (u.pm < 32) { float* nv = newv + ((((size_t)u.pm * 2 + l) * 8 + hh) * 256 + rt) * 64 + d0; *(f32x4*)nv = y0; *(f32x4*)(nv + 4) = y1; }
                    }
                    {
                        const int lane = fq * 16 + fr, sidx = m & 1;
                        bf16_t* cbase = vtc + (((size_t)u.pm * 256 + wr * 64 + ai * 128 + m * 16) >> 5) * 8 * 2048 + (size_t)hh * 2048;
#pragma unroll
                        for (int k = 0; k < 2; ++k) {
                            const int pc = lane + 64 * k, dim = pc >> 1, hi = pc & 1;
                            const u32x4 w = *(const LAS u32x4*)(T + dim * 16 + hi * 8);
                            *(u32x4*)(cbase + ((((dim >> 5) * 2 + sidx) * 2 + hi) * 32 + (dim & 31)) * 8) = w;
                        }
                    }
                    __builtin_amdgcn_sched_barrier(0);
                }
        } else {
            const bool isg = pn >= 10;
            bf16_t* dst = isg ? gates : misc; const int ld = isg ? 3072 : 1024; const int cb = (isg ? pn - 10 : pn - 6) * 256 + wc * 32 + 8 * fq;
#pragma unroll
            for (int ai = 0; ai < 2; ++ai)
                if (u.amask & (1 << ai))
#pragma unroll
                for (int m = 0; m < 4; ++m) {
                    const size_t row = (size_t)u.pm * 256 + rt0 + ai * 128 + m * 16;
#pragma unroll
                    for (int bj = 0; bj < 2; ++bj) {
                        f32x4 y0 = acc[ai][bj][m][0], y1 = acc[ai][bj][m][1];
                        if (isg) {
#pragma unroll
                            for (int j = 0; j < 4; ++j) { y0[j] = fmaxf(sigm(y0[j]), 1e-9f); y1[j] = fmaxf(sigm(y1[j]), 1e-9f); }
                        }
                        u32x4 w; w.x = pk(y0[0], y0[1]); w.y = pk(y0[2], y0[3]); w.z = pk(y1[0], y1[1]); w.w = pk(y1[2], y1[3]);
                        *(u32x4*)(dst + row * ld + cb + bj * 128) = w;
                    }
                    __builtin_amdgcn_sched_barrier(0);
                }
        }
    }
};
struct EpiBr {
    static constexpr bool PERM = true, CHAIN = true;
    const bf16_t* gates; bf16_t* mg;
    DI void operator()(f32x4 (&acc)[2][2][4][2], const Unit& u, int wr, int wc, int fr, int fq) const {
        const int r0 = u.pm * 256 + wr * 64 + fr, col0 = u.pn * 256 + wc * 32 + 8 * fq;
        const bf16_t* gp = gates + (size_t)r0 * 3072 + u.mode * 1024 + col0;
        bf16_t* mp = mg + (size_t)r0 * 1024 + col0;
        const bool fin = u.mode == 2;
        u32x4 na[2], nb[2], da[2], db[2];
#define BR_LD(nd, dd, it) do { const size_t rr_ = (size_t)(((it) >> 2) * 128 + ((it) & 3) * 16); _Pragma("unroll") for (int bj = 0; bj < 2; ++bj) { nd[bj] = *(const u32x4*)(gp + rr_ * 3072 + bj * 128); \
            if (!fin) dd[bj] = *(const u32x4*)(gp + rr_ * 3072 + 1024 + bj * 128); else dd[bj] = (u32x4){0u, 0u, 0u, 0u}; } } while (0)
#define BR_RT(x, y) (fin ? (x) : (x) * __builtin_amdgcn_rcpf(y))
#define BR_ST(nd, dd, it) do { const size_t rr_ = (size_t)(((it) >> 2) * 128 + ((it) & 3) * 16); _Pragma("unroll") for (int bj = 0; bj < 2; ++bj) { \
            const u32x4 gn = nd[bj], gd = dd[bj]; f32x4& a0 = acc[(it) >> 2][bj][(it) & 3][0]; f32x4& a1 = acc[(it) >> 2][bj][(it) & 3][1]; \
            a0[0] *= BR_RT(bflo(gn.x), bflo(gd.x)); a0[1] *= BR_RT(bfhi(gn.x), bfhi(gd.x)); a0[2] *= BR_RT(bflo(gn.y), bflo(gd.y)); a0[3] *= BR_RT(bfhi(gn.y), bfhi(gd.y)); \
            a1[0] *= BR_RT(bflo(gn.z), bflo(gd.z)); a1[1] *= BR_RT(bfhi(gn.z), bfhi(gd.z)); a1[2] *= BR_RT(bflo(gn.w), bflo(gd.w)); a1[3] *= BR_RT(bfhi(gn.w), bfhi(gd.w)); \
            if (fin) { u32x4 w; w.x = pk(a0[0], a0[1]); w.y = pk(a0[2], a0[3]); w.z = pk(a1[0], a1[1]); w.w = pk(a1[2], a1[3]); *(u32x4*)(mp + rr_ * 1024 + bj * 128) = w; } } } while (0)
#pragma unroll
        for (int ai = 0; ai < 2; ++ai)
            if (u.amask & (1 << ai)) {
                BR_LD(na, da, ai * 4);
#pragma unroll
                for (int it = ai * 4; it < ai * 4 + 4; it += 2) {
                    BR_LD(nb, db, it + 1);
                    BR_ST(na, da, it);
                    __builtin_amdgcn_sched_barrier(0);
                    if (it + 2 < ai * 4 + 4) BR_LD(na, da, it + 2);
                    BR_ST(nb, db, it + 1);
                    __builtin_amdgcn_sched_barrier(0);
                }
            }
#undef BR_LD
#undef BR_RT
#undef BR_ST
    }
};

struct Params { const float* in[29]; float* out; unsigned char* ws; int ph_lo, ph_hi; };

DI void phase_mod(float* lds, int l0, int nl, int rank, int nr) {
    const int tid = otid();
    float* sc = lds;
    float* red = lds + 5120;
    for (int i = tid; i < 5120; i += 512) { const int v = i >> 10, k = i & 1023; const float x = v == 0 ? IN(5)[k] : IN(4)[(v - 1) * 1024 + k]; sc[i] = silu(x); }
    __syncthreads();
    float* mod = (float*)(WSP + WS_MOD);
    const int l16 = tid & 15, kg = tid >> 4;
    for (int item = rank; item < nl * 144; item += nr) {
        const int l = l0 + item / 144, n0 = (item % 144) * 64;
        const float* w = IN(6) + ((size_t)l * 1024 + kg * 32) * 9216 + n0 + 4 * l16;
        f32x4 a[5];
#pragma unroll
        for (int v = 0; v < 5; ++v) a[v] = (f32x4){0.f, 0.f, 0.f, 0.f};
#pragma unroll 8
        for (int kk = 0; kk < 32; ++kk) {
            const f32x4 wv = *(const f32x4*)(w + (size_t)kk * 9216);
#pragma unroll
            for (int v = 0; v < 5; ++v) a[v] += wv * sc[v * 1024 + kg * 32 + kk];
        }
#pragma unroll
        for (int v = 0; v < 5; ++v) *(f32x4*)(red + (kg * 5 + v) * 64 + 4 * l16) = a[v];
        __syncthreads();
        if (tid < 320) { const int v = tid >> 6, cc = tid & 63; float s = IN(7)[l * 9216 + n0 + cc];
            for (int q = 0; q < 32; ++q) s += red[(q * 5 + v) * 64 + cc];
            mod[(l * 5 + v) * 9216 + n0 + cc] = s; }
        __syncthreads();
    }
}
DI void phase_cache(int lmask, int rank, int nr) {
    bf16_t* ck = (bf16_t*)(WSP + WS_CK); bf16_t* cvt = (bf16_t*)(WSP + WS_CVT);
    const int gt = rank * 512 + otid(), ng = nr * 512;
    for (int i = gt; i < 262144; i += ng) {
        const int d0 = (i & 7) * 8, keyg = (i >> 3) & 511, blh = i >> 12, key = keyg & 31;
        if (!((lmask >> ((blh >> 3) & 1)) & 1)) continue;
        const size_t cbase = ((size_t)blh * 16 + (keyg >> 5)) * 2048;
        const f32x4 k0 = *(const f32x4*)(IN(2) + (size_t)i * 8), k1 = *(const f32x4*)(IN(2) + (size_t)i * 8 + 4);
        u32x4 w; w.x = pk(k0[0], k0[1]); w.y = pk(k0[2], k0[3]); w.z = pk(k1[0], k1[1]); w.w = pk(k1[2], k1[3]);
        *(u32x4*)(ck + cbase + (((d0 >> 4) * 2 + ((d0 >> 3) & 1)) * 32 + key) * 8) = w;
        const f32x4 v0 = *(const f32x4*)(IN(3) + (size_t)i * 8), v1 = *(const f32x4*)(IN(3) + (size_t)i * 8 + 4);
        const int k16 = key & 15, grp = k16 >> 2;
        bf16_t* p = cvt + cbase + ((((d0 >> 5) * 2 + (key >> 4)) * 2 + (grp & 1)) * 32 + (d0 & 31)) * 8 + ((grp >> 1) * 4 + (k16 & 3));
        const unsigned w0 = pk(v0[0], v0[1]), w1 = pk(v0[2], v0[3]), w2 = pk(v1[0], v1[1]), w3 = pk(v1[2], v1[3]);
        p[0] = (bf16_t)w0; p[8] = (bf16_t)(w0 >> 16); p[16] = (bf16_t)w1; p[24] = (bf16_t)(w1 >> 16);
        p[32] = (bf16_t)w2; p[40] = (bf16_t)(w2 >> 16); p[48] = (bf16_t)w3; p[56] = (bf16_t)(w3 >> 16);
    }
}
template <int MAP> DI int rowmap(int j, int off) {
    if (MAP == 1) return 256 * (j >> 7) + off + (j & 127);
    if (MAP == 2) { if (j >= 1536) return j; const int t = j >> 8, w = j & 255; return 256 * t + 128 * ((w & 63) >> 5) + 32 * (w >> 6) + (w & 31); }
    return j;
}
template <int MAP, bool PANEL = false> DI void cvt_weight(const float* src, int K, int N, bf16_t* dst, int ldd, int koffd, int off, float* lds, int rank, int nr) {
    const int tid = otid(), ntn = N / 64, ntiles = (K / 64) * ntn, G = nr;
    for (int t0 = rank; t0 < ntiles; t0 += 4 * G) {
        float v[4][8];
#pragma unroll
        for (int q = 0; q < 4; ++q) { const int t = t0 + q * G; if (t < ntiles) { const int k0 = (t / ntn) * 64, j0 = (t % ntn) * 64;
#pragma unroll
            for (int i = 0; i < 8; ++i) v[q][i] = src[(size_t)(k0 + i * 8 + (tid >> 6)) * N + j0 + (tid & 63)]; } }
#pragma unroll
        for (int q = 0; q < 4; ++q) { const int t = t0 + q * G; if (t < ntiles) {
#pragma unroll
            for (int i = 0; i < 8; ++i) lds[q * 4160 + (i * 8 + (tid >> 6)) * 65 + (tid & 63)] = v[q][i]; } }
        __syncthreads();
#pragma unroll
        for (int q = 0; q < 4; ++q) { const int t = t0 + q * G; if (t < ntiles) { const int k0 = (t / ntn) * 64, j0 = (t % ntn) * 64;
            const int jj = tid >> 3, k8 = (tid & 7) * 8; float x[8];
#pragma unroll
            for (int e = 0; e < 8; ++e) x[e] = lds[q * 4160 + (k8 + e) * 65 + jj];
            u32x4 w; w.x = pk(x[0], x[1]); w.y = pk(x[2], x[3]); w.z = pk(x[4], x[5]); w.w = pk(x[6], x[7]);
            if (PANEL) *(u32x4*)(dst + ((size_t)(k0 >> 6) * N + (j0 + jj)) * 64 + k8) = w;
            else *(u32x4*)(dst + (size_t)rowmap<MAP>(j0 + jj, off) * ldd + koffd + k0 + k8) = w; } }
        __syncthreads();
    }
}
DI void phase_weights(int l, float* lds, int parts, int rank, int nr) {
    unsigned char* wb = WSP + WS_WB;
    if (parts & 1) { cvt_weight<1>(IN(9) + (size_t)l * 1024 * FF, 1024, FF, (bf16_t*)(wb + WB_GU1), 1024, 0, 0, lds, rank, nr);
                     cvt_weight<1>(IN(10) + (size_t)l * 1024 * FF, 1024, FF, (bf16_t*)(wb + WB_GU1), 1024, 0, 128, lds, rank, nr); }
    if (parts & 2) cvt_weight<0, true>(IN(11) + (size_t)l * FF * 1024, FF, 1024, (bf16_t*)(wb + WB_D1), FF, 0, 0, lds, rank, nr);
    if (parts & 4) cvt_weight<2>(IN(13) + (size_t)l * 1024 * INC, 1024, INC, (bf16_t*)(wb + WB_IN), 1024, 0, 0, lds, rank, nr);
    if (parts & 8) { cvt_weight<0>(IN(21) + (size_t)l * 512 * 1024, 512, 1024, (bf16_t*)(wb + WB_BR), 1024, 0, 0, lds, rank, nr);
                     cvt_weight<0>(IN(23) + (size_t)l * 256 * 1024, 256, 1024, (bf16_t*)(wb + WB_BR), 1024, 768, 0, lds, rank, nr); }
    if (parts & 16) cvt_weight<0>(IN(24) + (size_t)l * 1024 * 1024, 1024, 1024, (bf16_t*)(wb + WB_OUT), 1024, 0, 0, lds, rank, nr);
    if (parts & 32) { cvt_weight<1>(IN(26) + (size_t)l * 1024 * FF, 1024, FF, (bf16_t*)(wb + WB_GU2), 1024, 0, 0, lds, rank, nr);
                      cvt_weight<1>(IN(27) + (size_t)l * 1024 * FF, 1024, FF, (bf16_t*)(wb + WB_GU2), 1024, 0, 128, lds, rank, nr); }
    if (parts & 64) cvt_weight<0, true>(IN(28) + (size_t)l * FF * 1024, FF, 1024, (bf16_t*)(wb + WB_D2), FF, 0, 0, lds, rank, nr);
    if (parts & 8) {
        const float* wp = IN(17) + (size_t)l * 4 * 64 * 64; const float* ps = IN(18) + l * 256; const float* wbp = IN(22) + (size_t)l * 256 * 1024;
        bf16_t* br = (bf16_t*)(wb + WB_BR);
        for (int i = rank * 512 + otid(); i < 262144; i += nr * 512) {
            const int n = i & 1023, gc = i >> 10, g = gc >> 6;
            float s = 0.f;
            for (int d = 0; d < 64; ++d) s += wp[gc * 64 + d] * ps[g * 64 + d] * wbp[(size_t)(g * 64 + d) * 1024 + n];
            br[(size_t)n * 1024 + 512 + gc] = (bf16_t)pk(s, 0.f);
        }
    }
}
DI void phase_norm(const float* xc, const float* xl, bf16_t* hb, const float* g, const float* mod, int sidx) {
    const int tid = otid(), lane = tid & 63, gw = blockIdx.x * 8 + (tid >> 6), nw = gridDim.x * 8;
    for (int row0 = gw; row0 < TT; row0 += 4 * nw) {
        f32x4 v[4][4]; float ss[4];
#pragma unroll
        for (int q = 0; q < 4; ++q) { const int row = row0 + q * nw; ss[q] = 0.f;
            if (row < TT) { const float* xr = row < TC ? xc + (size_t)row * DM : xl + (size_t)(row - TC) * DM;
#pragma unroll
                for (int j = 0; j < 4; ++j) v[q][j] = *(const f32x4*)(xr + 4 * lane + 256 * j); } }
#pragma unroll
        for (int q = 0; q < 4; ++q) { const int row = row0 + q * nw;
            if (row < TT) {
#pragma unroll
                for (int j = 0; j < 4; ++j) ss[q] += (v[q][j][0] * v[q][j][0] + v[q][j][1] * v[q][j][1]) + (v[q][j][2] * v[q][j][2] + v[q][j][3] * v[q][j][3]);
#pragma unroll
                for (int o = 1; o < 64; o <<= 1) ss[q] += __shfl_xor(ss[q], o);
                const float r = rsqrtf(ss[q] * (1.0f / 1024.0f) + 1e-6f);
                const int bi = row < TC ? 0 : 1 + ((row - TC) >> 12);
                const float* sh = mod + (bi * NMOD + sidx) * DM; const float* sc = sh + DM;
#pragma unroll
                for (int j = 0; j < 4; ++j) {
                    const int c = 4 * lane + 256 * j;
                    const f32x4 gg = *(const f32x4*)(g + c), s1 = *(const f32x4*)(sc + c), s0 = *(const f32x4*)(sh + c);
                    const f32x4 y = v[q][j] * r * gg * (s1 + 1.0f) + s0;
                    u32x2 w; w.x = pk(y[0], y[1]); w.y = pk(y[2], y[3]);
                    *(u32x2*)(hb + (size_t)row * DM + c) = w;
                }
            } }
    }
}

struct AttnTask {
    const bf16_t* q;
    bf16_t* o;
    const bf16_t* kd; const bf16_t* vd; int dst; int nd;
    const bf16_t* kl; const bf16_t* vl; int nl;
    int r, rs, c, cs;
};
DI void attn_addr(const AttnTask& t, int ci, const bf16_t*& kp, const bf16_t*& vp) {
    if (ci < t.nd) { kp = t.kd + (size_t)ci * t.dst; vp = t.vd + (size_t)ci * t.dst; }
    else { const int li = ci - t.nd; const size_t off = (size_t)((t.rs + (li >> 1)) * 2 + (li & 1)) * 16384; kp = t.kl + off; vp = t.vl + off; }
}
DI void attn_load_k(const AttnTask& t, int ci, int lane, bf16x8 (&kf)[4]) {
    const bf16_t* kp; const bf16_t* vp; attn_addr(t, ci, kp, vp);
#pragma unroll
    for (int kk = 0; kk < 4; ++kk) kf[kk] = *(const bf16x8*)(kp + (kk * 64 + lane) * 8);
}
DI void attn_load_v(const AttnTask& t, int ci, int lane, bf16x8 (&vf)[4]) {
    const bf16_t* kp; const bf16_t* vp; attn_addr(t, ci, kp, vp);
#pragma unroll
    for (int f = 0; f < 4; ++f) vf[f] = *(const bf16x8*)(vp + (f * 64 + lane) * 8);
}
DI f32x16 attn_qk(const bf16x8 (&kf)[4], const bf16x8 (&qf)[4]) {
    f32x16 S;
#pragma unroll
    for (int i = 0; i < 16; ++i) S[i] = 0.f;
#pragma unroll
    for (int kk = 0; kk < 4; ++kk) S = __builtin_amdgcn_mfma_f32_32x32x16_bf16(kf[kk], qf[kk], S, 0, 0, 0);
    return S;
}
DI void attn_step(const AttnTask& t, const LAS float* rpb_lds, int ci, int hi, f32x16 S, const bf16x8 (&vf)[4], f32x16& O0, f32x16& O1, float& mrun, float& lrun) {
    if (ci >= t.nd) {
        const int li = ci - t.nd;
        const volatile LAS float* brow = rpb_lds + (t.rs + (li >> 1) - t.r + 7) * 31 - t.c + 15 + 32 * (li & 1) + 4 * hi;
        const int kc0 = 32 * (li & 1) + 4 * hi;
        float bias[16];
#pragma unroll
        for (int i = 0; i < 16; ++i) bias[i] = brow[8 * (i >> 2) + (i & 3)];
#pragma unroll
        for (int i = 0; i < 16; ++i) {
            const int kc = kc0 + 8 * (i >> 2) + (i & 3);
            const bool valid = (unsigned)(kc - t.cs) < 16u;
            const float sb = S[i] + bias[i];
            S[i] = valid ? sb : -1e30f;
        }
    }
    float mx = S[0];
#pragma unroll
    for (int i = 1; i < 16; ++i) mx = fmaxf(mx, S[i]);
    mx = xhalf_max(mx);
    if (__any(mx - mrun > 8.0f)) {
        const float mnew = fmaxf(mrun, mx), alpha = __builtin_amdgcn_exp2f(mrun - mnew);
        mrun = mnew; lrun *= alpha;
#pragma unroll
        for (int i = 0; i < 16; ++i) { O0[i] *= alpha; O1[i] *= alpha; }
    }
    float rs_ = 0.f;
#pragma unroll
    for (int i = 0; i < 16; ++i) { S[i] = __builtin_amdgcn_exp2f(S[i] - mrun); rs_ += S[i]; }
    lrun += rs_;
    bf16x8 pf[2];
#pragma unroll
    for (int s = 0; s < 2; ++s) {
        u32x4 w; w.x = pk(S[8 * s], S[8 * s + 1]); w.y = pk(S[8 * s + 2], S[8 * s + 3]); w.z = pk(S[8 * s + 4], S[8 * s + 5]); w.w = pk(S[8 * s + 6], S[8 * s + 7]);
        pf[s] = __builtin_bit_cast(bf16x8, w);
    }
#pragma unroll
    for (int s = 0; s < 2; ++s) { O0 = __builtin_amdgcn_mfma_f32_32x32x16_bf16(vf[s], pf[s], O0, 0, 0, 0); O1 = __builtin_amdgcn_mfma_f32_32x32x16_bf16(vf[2 + s], pf[s], O1, 0, 0, 0); }
}
DI void attn_task(const AttnTask& t, const LAS float* rpb_lds) {
    const int lane = otid() & 63, hi = lane >> 5;
    bf16x8 qf[4];
#pragma unroll
    for (int kk = 0; kk < 4; ++kk) qf[kk] = *(const bf16x8*)(t.q + 16 * kk + 8 * hi);
    f32x16 O0, O1;
#pragma unroll
    for (int i = 0; i < 16; ++i) { O0[i] = 0.f; O1[i] = 0.f; }
    float mrun = -1e30f, lrun = 0.f;
    const int nc = t.nd + t.nl;
    bf16x8 ka[4], kb[4], va[4], vb[4];
    attn_load_k(t, 0, lane, ka); attn_load_v(t, 0, lane, va); attn_load_k(t, 1, lane, kb);
    f32x16 Sa = attn_qk(ka, qf), Sb;
#pragma unroll 1
    for (int ci = 0; ci < nc; ci += 2) {
        attn_load_k(t, min(ci + 2, nc - 1), lane, ka); attn_load_v(t, ci + 1, lane, vb);
        Sb = attn_qk(kb, qf);
        attn_step(t, rpb_lds, ci, hi, Sa, va, O0, O1, mrun, lrun);
        attn_load_k(t, min(ci + 3, nc - 1), lane, kb); attn_load_v(t, min(ci + 2, nc - 1), lane, va);
        Sa = attn_qk(ka, qf);
        attn_step(t, rpb_lds, ci + 1, hi, Sb, vb, O0, O1, mrun, lrun);
    }
    lrun = xhalf_sum(lrun);
    const float inv = 1.0f / lrun;
#pragma unroll
    for (int g = 0; g < 4; ++g) {
        u32x2 w0, w1;
        w0.x = pk(O0[4 * g] * inv, O0[4 * g + 1] * inv); w0.y = pk(O0[4 * g + 2] * inv, O0[4 * g + 3] * inv);
        w1.x = pk(O1[4 * g] * inv, O1[4 * g + 1] * inv); w1.y = pk(O1[4 * g + 2] * inv, O1[4 * g + 3] * inv);
        *(u32x2*)(t.o + 8 * g + 4 * hi) = w0; *(u32x2*)(t.o + 32 + 8 * g + 4 * hi) = w1;
    }
}
DI void phase_mix(int l) {
    unsigned char* R = WSP + WS_R;
    const bf16_t* qb = (const bf16_t*)(R + R_Q); const bf16_t* kb = (const bf16_t*)(R + R_K); const bf16_t* vt = (const bf16_t*)(R + R_VT);
    const bf16_t* vtl = vt + (size_t)32 * 8 * 64 * 256;
    const bf16_t* misc = (const bf16_t*)(R + R_MISC);
    bf16_t* hb = (bf16_t*)(WSP + WS_HB);
    const bf16_t* ck = (const bf16_t*)(WSP + WS_CK); const bf16_t* cvt = (const bf16_t*)(WSP + WS_CVT);
    const int tid = otid(), lane = tid & 63, r31 = lane & 31, gw = blockIdx.x * 8 + (tid >> 6), nw = gridDim.x * 8;
    float* rl = (float*)shm;
    for (int i = tid; i < 3720; i += 512) rl[i] = IN(16)[l * 3720 + i] * 1.4426950408889634f;
    __syncthreads();
#pragma unroll 1
    for (int id = gw; id < 4096; id += nw) {
        const int qh = id & 1, r = (id >> 1) & 63, h = (id >> 7) & 7, b = id >> 10;
        const int t0 = TC + b * 4096 + r * 64 + 32 * qh;
        AttnTask t;
        t.q = qb + (size_t)(t0 + r31) * 512 + h * 64; t.o = hb + (size_t)(t0 + r31) * 1024 + h * 64;
        t.kd = ck + (size_t)((b * 2 + l) * 8 + h) * 16 * 2048; t.vd = cvt + (size_t)((b * 2 + l) * 8 + h) * 16 * 2048; t.dst = 2048; t.nd = 16;
        t.kl = kb + ((size_t)((TC + b * 4096) >> 5) * 8 + h) * 2048; t.vl = vt + ((size_t)((TC + b * 4096) >> 5) * 8 + h) * 2048; t.nl = 16;
        t.r = r; t.rs = min(max(r - 4, 0), 56); t.c = 32 * qh + r31; t.cs = min(max(t.c - 8, 0), 48);
        attn_task(t, (const LAS float*)shm + h * 465);
    }
#pragma unroll 1
    for (int id = gw; id < 2048; id += nw) {
        const int qbk = id & 7, h = (id >> 3) & 7, b = id >> 6;
        const int t0 = b * 256 + 32 * qbk;
        AttnTask t;
        t.q = qb + (size_t)(t0 + r31) * 512 + h * 64; t.o = hb + (size_t)(t0 + r31) * 1024 + h * 64;
        t.kd = kb + ((size_t)(b * 8) * 8 + h) * 2048; t.vd = vt + ((size_t)(b * 8) * 8 + h) * 2048; t.dst = 16384; t.nd = 8;
        t.kl = t.kd; t.vl = t.vd; t.nl = 0; t.r = 0; t.rs = 0; t.c = 0; t.cs = 0;
        attn_task(t, (const LAS float*)shm);
    }
}
DI void phase_poolconv(int l) {
    const bf16_t* misc = (const bf16_t*)(WSP + WS_R + R_MISC); bf16_t* hb = (bf16_t*)(WSP + WS_HB);
    const int tid = otid(), lane = tid & 63, gw = blockIdx.x * 8 + (tid >> 6), nw = gridDim.x * 8;
    const float* wcv = IN(19) + l * 768; const float* bcv = IN(20) + l * 256;
#pragma unroll 1
    for (int wi = gw; wi < (TT / 8) * 8; wi += nw) {
        const int g = wi & 7, tk = (wi >> 3) * 8 + (lane >> 3), ch = g * 64 + (lane & 7) * 8;
        int base, L; if (tk < TC) { base = tk & ~255; L = 256; } else { base = TC + ((tk - TC) & ~4095); L = 4096; }
        const int tl = tk - base;
        float o[8];
        if (g < 4) {
            const bf16_t* up = misc + (size_t)base * 1024 + ch;
            const u32x4 u = *(const u32x4*)(up + (size_t)tl * 1024);
            float s[8];
#pragma unroll
            for (int e = 0; e < 8; ++e) s[e] = 0.f;
            int cnt = 0;
#define POOL_W(W) do { _Pragma("unroll") for (int j = 0; j < W; ++j) { const int q = tl - W / 2 + j; const bool ok = q >= 0 && q < L; const int qq = min(max(q, 0), L - 1); \
                const u32x4 v = *(const u32x4*)(up + (size_t)qq * 1024); const float f = ok ? 1.0f : 0.0f; cnt += ok ? 1 : 0; \
                s[0] += f * bflo(v.x); s[1] += f * bfhi(v.x); s[2] += f * bflo(v.y); s[3] += f * bfhi(v.y); s[4] += f * bflo(v.z); s[5] += f * bfhi(v.z); s[6] += f * bflo(v.w); s[7] += f * bfhi(v.w); } } while (0)
            if (g == 0) POOL_W(2); else if (g == 1) POOL_W(4); else if (g == 2) POOL_W(8); else POOL_W(16);
#undef POOL_W
            const float inv = 1.0f / (float)cnt;
            o[0] = s[0] * inv - bflo(u.x); o[1] = s[1] * inv - bfhi(u.x); o[2] = s[2] * inv - bflo(u.y); o[3] = s[3] * inv - bfhi(u.y);
            o[4] = s[4] * inv - bflo(u.z); o[5] = s[5] * inv - bfhi(u.z); o[6] = s[6] * inv - bflo(u.w); o[7] = s[7] * inv - bfhi(u.w);
        } else {
            const int cc = ch - 256;
            const bf16_t* row0 = misc + (size_t)base * 1024;
            const u32x4 gb = *(const u32x4*)(row0 + (size_t)tl * 1024 + 512 + cc);
#pragma unroll
            for (int e = 0; e < 8; ++e) o[e] = bcv[cc + e];
#pragma unroll
            for (int j = 0; j < 3; ++j) {
                const int q = tl + j - 1; const bool ok = q >= 0 && q < L; const int qq = min(max(q, 0), L - 1); const float f = ok ? 1.0f : 0.0f;
                const bf16_t* row = row0 + (size_t)qq * 1024;
                const u32x4 uc = *(const u32x4*)(row + 256 + cc), gc = *(const u32x4*)(row + 768 + cc);
                const float* wj = wcv + j * 256 + cc;
                o[0] += f * wj[0] * bflo(uc.x) * bflo(gc.x); o[1] += f * wj[1] * bfhi(uc.x) * bfhi(gc.x); o[2] += f * wj[2] * bflo(uc.y) * bflo(gc.y); o[3] += f * wj[3] * bfhi(uc.y) * bfhi(gc.y);
                o[4] += f * wj[4] * bflo(uc.z) * bflo(gc.z); o[5] += f * wj[5] * bfhi(uc.z) * bfhi(gc.z); o[6] += f * wj[6] * bflo(uc.w) * bflo(gc.w); o[7] += f * wj[7] * bfhi(uc.w) * bfhi(gc.w);
            }
            o[0] *= bflo(gb.x); o[1] *= bfhi(gb.x); o[2] *= bflo(gb.y); o[3] *= bfhi(gb.y); o[4] *= bflo(gb.z); o[5] *= bfhi(gb.z); o[6] *= bflo(gb.w); o[7] *= bfhi(gb.w);
        }
        u32x4 w; w.x = pk(o[0], o[1]); w.y = pk(o[2], o[3]); w.z = pk(o[4], o[5]); w.w = pk(o[6], o[7]);
        *(u32x4*)(hb + (size_t)tk * 1024 + 512 + ch) = w;
    }
}

#define XB_TMO      128
#define XB_XCNT(j)  (256  + 64 * (j))
#define XB_XSUB(j)  (1280 + 64 * (j))
#define XB_XGEN(j)  (2304 + 64 * (j))
#define XB_TOP      3328
#define XB_TOPGEN   3392
#define XCD_BAR_WORDS 3456
#define XB_SPIN_CAP (1u << 22)
DI unsigned xb_ld(unsigned* p)              { return __hip_atomic_load(p, __ATOMIC_RELAXED, __HIP_MEMORY_SCOPE_AGENT); }
DI unsigned xb_add(unsigned* p, unsigned v) { return __hip_atomic_fetch_add(p, v, __ATOMIC_RELAXED, __HIP_MEMORY_SCOPE_AGENT); }
DI unsigned xb_xcc_id() { return (unsigned)__builtin_amdgcn_s_getreg((3 << 11) | 20) & 0xFu; }
#define XB_SPIN(cond, bar) do { unsigned _sp = 0; while (cond) { __builtin_amdgcn_s_sleep(1); \
    if ((++_sp & 255u) == 0u) { if (xb_ld(&(bar)[XB_TMO])) break; if (_sp > XB_SPIN_CAP) { atomicAdd(&(bar)[XB_TMO], 1u); break; } } } } while (0)
DI void xcd_barrier_complete(unsigned* bar, unsigned x, unsigned& nloc, unsigned& nx) {
    const unsigned G = gridDim.x;
    unsigned sum, cnt, mine, sp = 0u;
    for (;;) {
        sum = 0u; cnt = 0u; mine = 0u;
#pragma unroll
        for (unsigned j = 0; j < 16; ++j) { const unsigned c = xb_ld(&bar[XB_XCNT(j)]); sum += c; cnt += (c > 0u) ? 1u : 0u; mine = (j == x) ? c : mine; }
        if (sum == G) break;
        __builtin_amdgcn_s_sleep(1);
        if ((++sp & 255u) == 0u) { if (xb_ld(&bar[XB_TMO])) break; if (sp > XB_SPIN_CAP) { atomicAdd(&bar[XB_TMO], 1u); break; } }
    }
    nloc = mine > 0u ? mine : 1u; nx = cnt > 0u ? cnt : 1u;
}
DI void xcd_barrier() {
    asm volatile("s_waitcnt vmcnt(0)" ::: "memory");
    __syncthreads();
    if (threadIdx.x == 0) {
        unsigned* bar = (unsigned*)(WSP + WS_BAR);
        volatile LAS unsigned* st = (volatile LAS unsigned*)((LAS unsigned char*)shm + 131072 + 256);
        const unsigned x = xb_xcc_id();
        __builtin_amdgcn_s_waitcnt(0);
        unsigned nloc = st[0], nx = st[1];
        if (nloc == 0u) { xcd_barrier_complete(bar, x, nloc, nx); st[0] = nloc; st[1] = nx; }
        const unsigned old = xb_add(&bar[XB_XSUB(x)], 1u);
        const unsigned gen = old / nloc;
        if (old + 1u == (gen + 1u) * nloc) {
            __builtin_amdgcn_fence(__ATOMIC_RELEASE, "agent");
            asm volatile("s_waitcnt vmcnt(0)" ::: "memory");
            const unsigned og = xb_add(&bar[XB_TOP], 1u);
            const unsigned tg = og / nx;
            if (og + 1u == (tg + 1u) * nx) xb_add(&bar[XB_TOPGEN], 1u);
            else XB_SPIN(xb_ld(&bar[XB_TOPGEN]) == tg, bar);
            __builtin_amdgcn_fence(__ATOMIC_ACQUIRE, "agent");
            xb_add(&bar[XB_XGEN(x)], 1u);
            asm volatile("s_waitcnt vmcnt(0)" ::: "memory");
        } else {
            XB_SPIN(xb_ld(&bar[XB_XGEN(x)]) == gen, bar);
            __builtin_amdgcn_fence(__ATOMIC_ACQUIRE, "agent");
            asm volatile("s_waitcnt vmcnt(0)" ::: "memory");
        }
    }
    __syncthreads();
}

__global__ __launch_bounds__(512, 2) void mega(Params p) {
    cg::grid_group grid = cg::this_grid();
    if (threadIdx.x == 0) {
        LAS unsigned long long* tb = (LAS unsigned long long*)((LAS unsigned char*)shm + 131072);
#pragma unroll
        for (int i = 0; i < 29; ++i) tb[i] = (unsigned long long)p.in[i];
        tb[29] = (unsigned long long)p.out; tb[30] = (unsigned long long)p.ws;
        tb[32] = 0ull;
        (void)xb_add(&((unsigned*)(p.ws + WS_BAR))[XB_XCNT(xb_xcc_id())], 1u);
    }
    __syncthreads();
    const int ph_lo = p.ph_lo, ph_hi = p.ph_hi;
    for (int ph = ph_lo; ph < ph_hi; ++ph) {
        if (ph > ph_lo) { if (ph_hi > 4 * NPH) grid.sync(); else xcd_barrier(); if (REPMASK & 4096) xcd_barrier(); }
        LAS unsigned char* lds = (LAS unsigned char*)shm;
        float* ldsf = (float*)shm;
        if (ph == 0) {
            const bool defer = gridDim.x == 256;
            phase_mod(ldsf, 0, defer ? 1 : 2, blockIdx.x, gridDim.x); phase_cache(defer ? 1 : 3, blockIdx.x, gridDim.x); phase_weights(0, ldsf, 127, blockIdx.x, gridDim.x);
            continue; }
        const int l = (ph - 1) / 11, s = (ph - 1) % 11;
        unsigned char* ws = WSP; float* xo = OUTP;
        unsigned char* wb = ws + WS_WB; unsigned char* R = ws + WS_R;
        bf16_t* hb = (bf16_t*)(ws + WS_HB); bf16_t* act = (bf16_t*)(R); bf16_t* mg = (bf16_t*)(R + R_Q);
        const float* xoc = xo; const float* xol = xo + (size_t)TC * DM;
        const float* mod = (const float*)(ws + WS_MOD) + (size_t)l * 5 * 9216;
        Order S; Gemm g; g.ksa = 128; g.ksb = 128;
        const bool early = gridDim.x == 256;
        for (int rep = 0; rep < (((REPMASK >> s) & 1) ? 2 : 1); ++rep) {
        if (rep) __syncthreads();
        switch (s) {
        case 0: if (l > 0) phase_weights(l, ldsf, early ? 127 & ~(1 | 4 | 32) : 127, blockIdx.x, gridDim.x); phase_norm(l == 0 ? IN(0) : xoc, l == 0 ? IN(1) : xol, hb, IN(8) + l * DM, mod, 0); break;
        case 1: { S.init(96, 22, 16, 1); g.A = hb; g.Bt = (const bf16_t*)(wb + WB_GU1); g.lda = 1024; g.ldb = 1024; EpiSwiGLU E; E.O = act; gemm_phase(lds, g, S, E);
                  if (early && l == 1 && blockIdx.x >= 128) phase_weights(1, ldsf, 32, blockIdx.x - 128, 128);
                  if (early && l == 0 && blockIdx.x >= 128) { phase_mod(ldsf, 1, 1, blockIdx.x - 128, 128); phase_cache(2, blockIdx.x - 128, 128); } } break;
        case 2: { S.init(96, 4, 44, 1); g.A = act; g.Bt = (const bf16_t*)(wb + WB_D1); g.lda = 64; g.ldb = 64; g.ksa = (size_t)TT * 128; g.ksb = (size_t)1024 * 128; EpiResid E; E.xin_c = l == 0 ? IN(0) : xoc; E.xin_l = l == 0 ? IN(1) : xol; E.xout = xo; E.mod = mod; E.gidx = 2; E.gs = 0.5f; gemm_phase(lds, g, S, E); } break;
        case 3: phase_norm(xoc, xol, hb, IN(12) + l * DM, mod, 3); break;
        case 4: { S.init(96, 22, 16, 1); g.A = hb; g.Bt = (const bf16_t*)(wb + WB_IN); g.lda = 1024; g.ldb = 1024; EpiIn E;
                  E.qb = (bf16_t*)(R + R_Q); E.kb = (bf16_t*)(R + R_K); E.vtc = (bf16_t*)(R + R_VT); E.vtl = E.vtc + (size_t)32 * 8 * 64 * 256; E.misc = (bf16_t*)(R + R_MISC); E.gates = (bf16_t*)(R + R_GATES);
                  E.newk = xo + OUT_NEWK; E.newv = xo + OUT_NEWV; E.gq = IN(14) + l * 64; E.gk = IN(15) + l * 64; E.l = l; gemm_phase(lds, g, S, E);
                  if (early && l == 0 && blockIdx.x >= 128) phase_weights(1, ldsf, 1, blockIdx.x - 128, 128); } break;
        case 5: phase_mix(l); if (REPMASK & 8192) { __syncthreads(); phase_mix(l); } phase_poolconv(l); if (REPMASK & 16384) phase_poolconv(l); break;
        case 6: { S.init(96, 4, 0, 3); g.A = hb; g.Bt = (const bf16_t*)(wb + WB_BR); g.lda = 1024; g.ldb = 1024; EpiBr E; E.gates = (const bf16_t*)(R + R_GATES); E.mg = mg; gemm_phase(lds, g, S, E); } break;
        case 7: { S.init(96, 4, 16, 1); g.A = mg; g.Bt = (const bf16_t*)(wb + WB_OUT); g.lda = 1024; g.ldb = 1024; EpiResid E; E.xin_c = xoc; E.xin_l = xol; E.xout = xo; E.mod = mod; E.gidx = 5; E.gs = 1.0f; gemm_phase(lds, g, S, E); } break;
        case 8: phase_norm(xoc, xol, hb, IN(25) + l * DM, mod, 6); break;
        case 9: { S.init(96, 22, 16, 1); g.A = hb; g.Bt = (const bf16_t*)(wb + WB_GU2); g.lda = 1024; g.ldb = 1024; EpiSwiGLU E; E.O = act; gemm_phase(lds, g, S, E);
                  if (early && l == 0 && blockIdx.x >= 128) phase_weights(1, ldsf, 4, blockIdx.x - 128, 128); } break;
        case 10: { S.init(96, 4, 44, 1); g.A = act; g.Bt = (const bf16_t*)(wb + WB_D2); g.lda = 64; g.ldb = 64; g.ksa = (size_t)TT * 128; g.ksb = (size_t)1024 * 128; EpiResid E; E.xin_c = xoc; E.xin_l = xol; E.xout = xo; E.mod = mod; E.gidx = 8; E.gs = 0.5f; gemm_phase(lds, g, S, E); } break;
        }
        }
    }
}

extern "C" void kernel_launch(void* const* d_in, const int* in_sizes, int n_in, void* d_out, int out_size, void* d_ws, size_t ws_size, hipStream_t stream) {
    static int grid = 0;
    if (grid == 0) {
        if (n_in != 29 || ws_size < WS_END) { fprintf(stderr, "kernel_launch: bad n_in %d or ws %zu < %zu\n", n_in, ws_size, (size_t)WS_END); grid = -1; return; }
        int dev = 0, cus = 0, per_cu = 0;
        hipGetDevice(&dev); hipDeviceGetAttribute(&cus, hipDeviceAttributeMultiprocessorCount, dev);
        if (hipFuncSetAttribute((const void*)mega, hipFuncAttributeMaxDynamicSharedMemorySize, LDS_BYTES) != hipSuccess) { fprintf(stderr, "hipFuncSetAttribute failed\n"); grid = -1; return; }
        hipOccupancyMaxActiveBlocksPerMultiprocessor(&per_cu, (const void*)mega, 512, LDS_BYTES);
        (void)hipGetLastError();
        if (per_cu < 1) per_cu = 1;
        grid = cus * per_cu;
    }
    if (grid < 0) return;
    if (hipMemsetAsync((char*)d_ws + WS_BAR, 0, 16384, stream) != hipSuccess) { fprintf(stderr, "memset failed\n"); return; }
    Params p{};
    for (int i = 0; i < 29; ++i) p.in[i] = (const float*)d_in[i];
    p.out = (float*)d_out; p.ws = (unsigned char*)d_ws; p.ph_lo = 0; p.ph_hi = PHI;
    void* args[] = {&p};
    hipError_t e = hipLaunchCooperativeKernel((const void*)mega, dim3(grid), dim3(512), args, LDS_BYTES, stream);
    if (e != hipSuccess) fprintf(stderr, "cooperative launch failed: %s (grid %d)\n", hipGetErrorString(e), grid);
}
```

```cpp
#include <hip/hip_runtime.h>
#include <hip/hip_cooperative_groups.h>
#include <cstdio>
namespace cg = cooperative_groups;

#define LAS __attribute__((address_space(3)))
#define DI __device__ __forceinline__
typedef unsigned short bf16_t;
typedef short bf16x8 __attribute__((ext_vector_type(8)));
typedef short s16x4 __attribute__((ext_vector_type(4)));
typedef float f32x2 __attribute__((ext_vector_type(2)));
typedef float f32x4 __attribute__((ext_vector_type(4)));
typedef float f32x16 __attribute__((ext_vector_type(16)));
typedef unsigned u32x2 __attribute__((ext_vector_type(2)));
typedef unsigned u32x4 __attribute__((ext_vector_type(4)));
typedef __bf16 bf2_t __attribute__((ext_vector_type(2)));

constexpr int DM = 1024, TC = 8192, TL = 16384, TT = TC + TL, FF = 2816, INC = 5632, NMOD = 9;
constexpr int NPH = 23;
#ifndef PHI
#define PHI NPH
#endif
#ifndef REPMASK
#define REPMASK 0
#endif
constexpr size_t OUT_NEWK = 25165824, OUT_NEWV = 33554432;
constexpr size_t WS_MOD = 0;
constexpr size_t WS_CK = 368640;
constexpr size_t WS_CVT = WS_CK + 4194304;
constexpr size_t WS_WB = WS_CVT + 4194304;
constexpr size_t WB_GU1 = 0, WB_D1 = WB_GU1 + 11534336, WB_IN = WB_D1 + 5767168, WB_BR = WB_IN + 11534336, WB_OUT = WB_BR + 2097152,
                 WB_GU2 = WB_OUT + 2097152, WB_D2 = WB_GU2 + 11534336, WB_END = WB_D2 + 5767168;
constexpr size_t WS_HB = WS_WB + WB_END;
constexpr size_t WS_R = WS_HB + 50331648;
constexpr size_t R_Q = 0, R_K = 25165824, R_VT = 50331648, R_MISC = 75497472, R_GATES = 125829120, R_END = 276824064;
constexpr size_t WS_BAR = WS_R + R_END;
constexpr size_t WS_END = WS_BAR + 16384;
constexpr int LDS_BYTES = 131072 + 512 + 8 * 2048;

DI unsigned pk(float a, float b) { f32x2 v = {a, b}; bf2_t r = __builtin_convertvector(v, bf2_t); return __builtin_bit_cast(unsigned, r); }
DI float bflo(unsigned w) { return __uint_as_float(w << 16); }
DI float bfhi(unsigned w) { return __uint_as_float(w & 0xffff0000u); }
DI float xhalf_max(float x) { const unsigned u = __float_as_uint(x); const auto r = __builtin_amdgcn_permlane32_swap(u, u, false, false); return fmaxf(__uint_as_float(r[0]), __uint_as_float(r[1])); }
DI float xhalf_sum(float x) { const unsigned u = __float_as_uint(x); const auto r = __builtin_amdgcn_permlane32_swap(u, u, false, false); return __uint_as_float(r[0]) + __uint_as_float(r[1]); }
DI float sigm(float x) { return __builtin_amdgcn_rcpf(1.0f + __expf(-x)); }
DI float silu(float x) { return x * sigm(x); }
extern __shared__ __attribute__((aligned(16))) unsigned char shm[];
DI unsigned long long ldq(int i) { const unsigned long long v = ((volatile LAS unsigned long long*)((LAS unsigned char*)shm + 131072))[i];
    const unsigned hi = (unsigned)__builtin_amdgcn_readfirstlane((int)(unsigned)(v >> 32)), lo = (unsigned)__builtin_amdgcn_readfirstlane((int)(unsigned)v);
    return ((unsigned long long)hi << 32) | (unsigned long long)lo; }
template <class T> DI T* gptr(unsigned long long v) { typedef __attribute__((address_space(1))) T GT; GT* g = (GT*)v; return (T*)g; }
#define IN(i) (gptr<const float>(ldq(i)))
#define OUTP (gptr<float>(ldq(29)))
#define WSP (gptr<unsigned char>(ldq(30)))
DI int otid() { int t = threadIdx.x; asm volatile("" : "+v"(t)); return t; }

constexpr int HTB = 128 * 64 * 2;
DI int lds_byte(int r, int c) { const int st = (r >> 4) * 2 + (c >> 5), rr = r & 15, cc = c & 31, ob = rr * 64 + cc * 2; return st * 1024 + (ob ^ (((ob >> 9) & 1) << 5)); }
DI void stage_rc(int b, int& R, int& C) { const int st = b / 1024, sb = b % 1024, swz = sb ^ (((sb >> 9) & 1) << 5); R = (st >> 1) * 16 + swz / 64; C = (st & 1) * 32 + (swz % 64) / 2; }
DI int perm32(int rho) { const int n = rho >> 4, i = rho & 15; return 8 * (i >> 2) + 4 * n + (i & 3); }

struct Unit { int pm, pn, koff, nt, mode, amask; };
struct Gemm { const bf16_t* A; const bf16_t* Bt; int lda, ldb; size_t ksa, ksb; };
struct Order {
    int nM, nN, nwg, G, c, nsub, ntk;
    DI void init(int nM_, int nN_, int ntk_, int nsub_) { nM = nM_; nN = nN_; nwg = nM * nN; G = (int)gridDim.x; c = (int)blockIdx.x; nsub = nsub_; ntk = ntk_; }
    DI bool next(int i, Unit& u) const {
        int ii = i, s = 0; if (nsub == 3) { ii = i / 3; s = i - 3 * ii; }
        int wgid; u.amask = 3;
        if (G == 256 && nwg == 384) {
            if (ii == 0) wgid = 32 * (c & 7) + (c >> 3);
            else if (ii == 1) { wgid = 256 + 16 * (c & 7) + (c >> 4); u.amask = 1 << ((c >> 3) & 1); }
            else return false;
        } else {
            long L = (long)ii * G + c;
            if (G == 256 && (nwg & 7) == 0) {
                const int nfull = nwg >> 8;
                if (ii > nfull) return false;
                if (ii == nfull) { const int idx = ((c >> 4) << 3) + (c & 7); if (idx >= nwg - (nfull << 8)) return false; L = (nfull << 8) + idx; u.amask = 1 << ((c >> 3) & 1); }
            }
            if (L >= nwg) return false;
            wgid = (int)L; { const int q = nwg / 8, r = nwg % 8, xcd = wgid % 8, off = wgid / 8; wgid = (xcd < r ? xcd * (q + 1) : r * (q + 1) + (xcd - r) * q) + off; }
        }
        const int nig = 8 * nN, gid = wgid / nig, fm = gid * 8, gsz = (nM - fm) < 8 ? (nM - fm) : 8;
        u.pm = fm + ((wgid % nig) % gsz); u.pn = (wgid % nig) / gsz;
        if (nsub == 3) { u.mode = s; u.koff = s == 0 ? 0 : (s == 1 ? 512 : 768); u.nt = s == 0 ? 8 : 4; }
        else { u.mode = 0; u.koff = 0; u.nt = ntk; }
        return true;
    }
};

template <class Epi>
DI void gemm_phase(LAS unsigned char* lds, const Gemm g, const Order& S, const Epi& E) {
    const int tid = otid(), wid = __builtin_amdgcn_readfirstlane(tid >> 6), lane = tid & 63, wr = wid >> 2, wc = wid & 3, fr = lane & 15, fq = lane >> 4;
    unsigned voffA[2], voffB[2];
#pragma unroll
    for (int i = 0; i < 2; ++i) { int R, C; stage_rc(tid * 16 + i * 8192, R, C); const int Rb = Epi::PERM ? ((R & ~31) + perm32(R & 31)) : R;
        voffA[i] = (unsigned)(R * g.lda + C) * 2u; voffB[i] = (unsigned)(Rb * g.ldb + C) * 2u; }
    const size_t kstepA = g.ksa, kstepB = g.ksb;
    const size_t hstepA = (size_t)128 * g.lda * 2, hstepB = (size_t)128 * g.ldb * 2;
    const unsigned ldsw = (unsigned)wid * 1024u;
    const int aoff = lds_byte(wr * 64 + fr, fq * 8), boff = lds_byte(wc * 32 + fr, fq * 8);
#define PG8_SA(b, h) (((b) * 2 + (h)) * HTB)
#define PG8_SB(b, h) ((4 + (b) * 2 + (h)) * HTB)
#define PG8_STAGE(bufoff, gbase, voff) do { _Pragma("unroll") for (int _i = 0; _i < 2; ++_i) \
        __builtin_amdgcn_global_load_lds((const unsigned*)((const char*)(gbase) + (voff)[_i]), (LAS unsigned*)(lds + (bufoff) + ldsw + _i * 8192), 16, 0, 0); } while (0)
#define PG8_LDA(dst, b, h) do { _Pragma("unroll") for (int m = 0; m < 4; ++m) _Pragma("unroll") for (int k = 0; k < 2; ++k) dst[m][k] = *(const LAS bf16x8*)(lds + PG8_SA(b, h) + aoff + m * 2048 + k * 1024); } while (0)
#define PG8_LDB(dst, b, h) do { _Pragma("unroll") for (int n = 0; n < 2; ++n) _Pragma("unroll") for (int k = 0; k < 2; ++k) dst[n][k] = *(const LAS bf16x8*)(lds + PG8_SB(b, h) + boff + n * 2048 + k * 1024); } while (0)
#define PG8_MMA(ai, bj, At, Bt) do { if (cur.amask & (1 << (ai))) { __builtin_amdgcn_s_setprio(1); _Pragma("unroll") for (int m = 0; m < 4; ++m) _Pragma("unroll") for (int n = 0; n < 2; ++n) _Pragma("unroll") for (int k = 0; k < 2; ++k) \
        acc[ai][bj][m][n] = __builtin_amdgcn_mfma_f32_16x16x32_bf16(Bt[n][k], At[m][k], acc[ai][bj][m][n], 0, 0, 0); __builtin_amdgcn_s_setprio(0); } } while (0)
#define PG8_WAIT_V(n) asm volatile("s_waitcnt vmcnt(" #n ")" ::: "memory")
#define PG8_WAIT_L(n) asm volatile("s_waitcnt lgkmcnt(" #n ")" ::: "memory")
#define PG8_BAR __builtin_amdgcn_s_barrier()
#define PG8_SCHED __builtin_amdgcn_sched_barrier(0)
    Unit cur, nxt; int ui = 0;
    if (!S.next(0, cur)) return;
    f32x4 acc[2][2][4][2];
#pragma unroll
    for (int a = 0; a < 2; ++a)
#pragma unroll
        for (int b = 0; b < 2; ++b)
#pragma unroll
            for (int m = 0; m < 4; ++m)
#pragma unroll
                for (int n = 0; n < 2; ++n) acc[a][b][m][n] = (f32x4){0.f, 0.f, 0.f, 0.f};
    bf16x8 At[4][2], B0[2][2], B1[2][2];
    const char* cA = (const char*)g.A + ((size_t)cur.pm * 256 * g.lda + cur.koff) * 2; const char* cB = (const char*)g.Bt + ((size_t)cur.pn * 256 * g.ldb + cur.koff) * 2;
    PG8_STAGE(PG8_SB(0, 0), cB, voffB); PG8_STAGE(PG8_SA(0, 0), cA, voffA); PG8_STAGE(PG8_SB(0, 1), cB + hstepB, voffB); PG8_STAGE(PG8_SA(0, 1), cA + hstepA, voffA);
    if (wr == 1) PG8_BAR;
    PG8_WAIT_V(4); PG8_BAR;
    PG8_STAGE(PG8_SB(1, 0), cB + kstepB, voffB); PG8_STAGE(PG8_SA(1, 0), cA + kstepA, voffA); PG8_STAGE(PG8_SB(1, 1), cB + hstepB + kstepB, voffB);
    PG8_WAIT_V(6); PG8_BAR;
    for (;;) {
        const bool has_next = S.next(ui + 1, nxt);
        const char* nA = has_next ? (const char*)g.A + ((size_t)nxt.pm * 256 * g.lda + nxt.koff) * 2 : cA;
        const char* nB = has_next ? (const char*)g.Bt + ((size_t)nxt.pn * 256 * g.ldb + nxt.koff) * 2 : cB;
        const int nt = cur.nt;
        for (int t = 0; t < nt; t += 2) {
            const bool last = (t == nt - 2);
            const char* a1 = cA + (size_t)(t + 1) * kstepA;
            const char* a2 = last ? nA : cA + (size_t)(t + 2) * kstepA; const char* b2 = last ? nB : cB + (size_t)(t + 2) * kstepB;
            const char* a3 = a2 + kstepA; const char* b3 = b2 + kstepB;
            PG8_LDB(B0, 0, 0); PG8_SCHED; PG8_LDA(At, 0, 0); PG8_STAGE(PG8_SA(1, 1), a1 + hstepA, voffA);
            PG8_WAIT_L(8); PG8_BAR; PG8_WAIT_L(0); PG8_MMA(0, 0, At, B0); PG8_BAR; PG8_SCHED;
            PG8_LDB(B1, 0, 1); PG8_STAGE(PG8_SB(0, 0), b2, voffB);
            PG8_BAR; PG8_WAIT_L(0); PG8_MMA(0, 1, At, B1); PG8_BAR;
            PG8_LDA(At, 0, 1); PG8_STAGE(PG8_SA(0, 0), a2, voffA);
            PG8_BAR; PG8_WAIT_L(0); PG8_MMA(1, 0, At, B0); PG8_BAR; PG8_SCHED;
            PG8_STAGE(PG8_SB(0, 1), b2 + hstepB, voffB);
            PG8_WAIT_V(6); PG8_BAR; PG8_MMA(1, 1, At, B1); PG8_BAR;
            PG8_LDB(B0, 1, 0); PG8_SCHED; PG8_LDA(At, 1, 0); PG8_STAGE(PG8_SA(0, 1), a2 + hstepA, voffA);
            PG8_WAIT_L(8); PG8_BAR; PG8_WAIT_L(0); PG8_MMA(0, 0, At, B0); PG8_BAR; PG8_SCHED;
            PG8_LDB(B1, 1, 1); PG8_STAGE(PG8_SB(1, 0), b3, voffB);
            PG8_BAR; PG8_WAIT_L(0); PG8_MMA(0, 1, At, B1); PG8_BAR;
            PG8_LDA(At, 1, 1); PG8_STAGE(PG8_SA(1, 0), a3, voffA);
            PG8_BAR; PG8_WAIT_L(0); PG8_MMA(1, 0, At, B0); PG8_BAR; PG8_SCHED;
            PG8_STAGE(PG8_SB(1, 1), b3 + hstepB, voffB);
            PG8_WAIT_V(6); PG8_BAR; PG8_MMA(1, 1, At, B1); PG8_BAR;
        }
        { int fr2 = fr, fq2 = fq; asm volatile("" : "+v"(fr2), "+v"(fq2)); E(acc, cur, wr, wc, fr2, fq2); }
        if (!has_next) break;
        if (!(Epi::CHAIN && cur.mode < 2))
#pragma unroll
        for (int a = 0; a < 2; ++a)
#pragma unroll
            for (int b = 0; b < 2; ++b)
#pragma unroll
                for (int m = 0; m < 4; ++m)
#pragma unroll
                    for (int n = 0; n < 2; ++n) acc[a][b][m][n] = (f32x4){0.f, 0.f, 0.f, 0.f};
        cur = nxt; cA = nA; cB = nB; ++ui;
    }
    PG8_WAIT_V(0);
    if (wr == 0) PG8_BAR;
    PG8_BAR;
#undef PG8_SA
#undef PG8_SB
#undef PG8_STAGE
#undef PG8_LDA
#undef PG8_LDB
#undef PG8_MMA
#undef PG8_WAIT_V
#undef PG8_WAIT_L
#undef PG8_BAR
#undef PG8_SCHED
}

struct EpiSwiGLU {
    static constexpr bool PERM = true, CHAIN = false;
    bf16_t* O;
    DI void operator()(const f32x4 (&acc)[2][2][4][2], const Unit& u, int wr, int wc, int fr, int fq) const {
        const int row0 = u.pm * 256 + wr * 64 + fr, col0 = u.pn * 128 + wc * 32 + 8 * fq;
#pragma unroll
        for (int ai = 0; ai < 2; ++ai)
            if (u.amask & (1 << ai))
#pragma unroll
            for (int m = 0; m < 4; ++m) {
                const f32x4 g0 = acc[ai][0][m][0], g1 = acc[ai][0][m][1], u0 = acc[ai][1][m][0], u1 = acc[ai][1][m][1];
                u32x4 w;
                w.x = pk(silu(g0[0]) * u0[0], silu(g0[1]) * u0[1]); w.y = pk(silu(g0[2]) * u0[2], silu(g0[3]) * u0[3]);
                w.z = pk(silu(g1[0]) * u1[0], silu(g1[1]) * u1[1]); w.w = pk(silu(g1[2]) * u1[2], silu(g1[3]) * u1[3]);
                *(u32x4*)(O + ((size_t)(col0 >> 6) * TT + (row0 + ai * 128 + m * 16)) * 64 + (col0 & 63)) = w;
                if (m & 1) __builtin_amdgcn_sched_barrier(0);
            }
    }
};
struct EpiResid {
    static constexpr bool PERM = false, CHAIN = false;
    const float* xin_c; const float* xin_l; float* xout; const float* mod; int gidx; float gs;
    DI void operator()(const f32x4 (&acc)[2][2][4][2], const Unit& u, int wr, int wc, int fr, int fq) const {
        const int bi = u.pm < 32 ? 0 : 1 + ((u.pm - 32) >> 4);
        const float* mg = mod + (bi * NMOD + gidx) * DM;
        const int r0 = wr * 64 + fr, col0 = u.pn * 256 + wc * 32 + 4 * fq;
        const float* xi = (u.pm < 32 ? xin_c + (size_t)u.pm * 256 * DM : xin_l + (size_t)(u.pm - 32) * 256 * DM) + (size_t)r0 * DM + col0;
        float* xo = xout + (size_t)u.pm * 256 * DM + (size_t)r0 * DM + col0;
        f32x4 gv[2][2];
#pragma unroll
        for (int bj = 0; bj < 2; ++bj)
#pragma unroll
            for (int n = 0; n < 2; ++n) gv[bj][n] = *(const f32x4*)(mg + col0 + bj * 128 + n * 16) * gs;
        f32x4 xa[2][2], xb[2][2];
#define RESID_LD(dst, it) do { const size_t ro_ = (size_t)(((it) >> 2) * 128 + ((it) & 3) * 16) * DM; _Pragma("unroll") for (int bj = 0; bj < 2; ++bj) _Pragma("unroll") for (int n = 0; n < 2; ++n) dst[bj][n] = *(const f32x4*)(xi + ro_ + bj * 128 + n * 16); } while (0)
#define RESID_ST(src, it) do { const size_t ro_ = (size_t)(((it) >> 2) * 128 + ((it) & 3) * 16) * DM; _Pragma("unroll") for (int bj = 0; bj < 2; ++bj) _Pragma("unroll") for (int n = 0; n < 2; ++n) *(f32x4*)(xo + ro_ + bj * 128 + n * 16) = src[bj][n] + gv[bj][n] * acc[(it) >> 2][bj][(it) & 3][n]; } while (0)
#pragma unroll
        for (int ai = 0; ai < 2; ++ai)
            if (u.amask & (1 << ai)) {
                RESID_LD(xa, ai * 4);
#pragma unroll
                for (int it = ai * 4; it < ai * 4 + 4; it += 2) {
                    RESID_LD(xb, it + 1);
                    RESID_ST(xa, it);
                    __builtin_amdgcn_sched_barrier(0);
                    if (it + 2 < ai * 4 + 4) RESID_LD(xa, it + 2);
                    RESID_ST(xb, it + 1);
                    __builtin_amdgcn_sched_barrier(0);
                }
            }
#undef RESID_LD
#undef RESID_ST
    }
};
struct EpiIn {
    static constexpr bool PERM = true, CHAIN = false;
    bf16_t *qb, *kb, *vtc, *vtl, *misc, *gates; float *newk, *newv; const float *gq, *gk; int l;
    DI void operator()(const f32x4 (&acc)[2][2][4][2], const Unit& u, int wr, int wc, int fr, int fq) const {
        const int pn = u.pn, rt0 = wr * 64 + fr;
        if (pn < 4) {
            const bool isk = pn >= 2; const int hh = 4 * (pn & 1) + wc; const float* g = isk ? gk : gq; bf16_t* dst = isk ? kb : qb;
            f32x4 gg[2][2];
#pragma unroll
            for (int bj = 0; bj < 2; ++bj)
#pragma unroll
                for (int n = 0; n < 2; ++n) gg[bj][n] = *(const f32x4*)(g + 32 * bj + 8 * fq + 4 * n);
#pragma unroll
            for (int ai = 0; ai < 2; ++ai)
                if (u.amask & (1 << ai))
#pragma unroll
                for (int m = 0; m < 4; ++m) {
                    float ss = 0.f;
#pragma unroll
                    for (int bj = 0; bj < 2; ++bj)
#pragma unroll
                        for (int n = 0; n < 2; ++n) { const f32x4 v = acc[ai][bj][m][n]; ss += (v[0] * v[0] + v[1] * v[1]) + (v[2] * v[2] + v[3] * v[3]); }
                    ss += __shfl_xor(ss, 16); ss += __shfl_xor(ss, 32);
                    const float r = rsqrtf(ss * (1.0f / 64.0f) + 1e-6f) * (isk ? 1.0f : 0.18033688011112042f);
                    const int rt = rt0 + ai * 128 + m * 16; const size_t row = (size_t)u.pm * 256 + rt;
#pragma unroll
                    for (int bj = 0; bj < 2; ++bj) {
                        const f32x4 y0 = acc[ai][bj][m][0] * r * gg[bj][0], y1 = acc[ai][bj][m][1] * r * gg[bj][1];
                        u32x4 w; w.x = pk(y0[0], y0[1]); w.y = pk(y0[2], y0[3]); w.z = pk(y1[0], y1[1]); w.w = pk(y1[2], y1[3]);
                        if (isk) { const int d0 = 32 * bj + 8 * fq; *(u32x4*)(dst + ((row >> 5) * 8 + hh) * 2048 + (((d0 >> 4) * 2 + ((d0 >> 3) & 1)) * 32 + (row & 31)) * 8) = w; }
                        else *(u32x4*)(dst + row * 512 + hh * 64 + 32 * bj + 8 * fq) = w;
                        if (isk && u.pm < 32) { float* nk = newk + ((((size_t)u.pm * 2 + l) * 8 + hh) * 256 + rt) * 64 + 32 * bj + 8 * fq; *(f32x4*)nk = y0; *(f32x4*)(nk + 4) = y1; }
                    }
                    __builtin_amdgcn_sched_barrier(0);
                }
        } else if (pn < 6) {
            const int hh = 4 * (pn - 4) + wc;
#pragma unroll
            for (int ai = 0; ai < 2; ++ai)
                if (u.amask & (1 << ai))
#pragma unroll
                for (int m = 0; m < 4; ++m) {
                    const int rt = rt0 + ai * 128 + m * 16; const size_t row = (size_t)u.pm * 256 + rt;
                    LAS bf16_t* T = (LAS bf16_t*)((LAS unsigned char*)shm + 131584 + (wr * 4 + wc) * 2048);
                    const int pos = ((fr >> 2) & 1) * 8 + (fr >> 3) * 4 + (fr & 3);
#pragma unroll
                    for (int bj = 0; bj < 2; ++bj) {
                        const f32x4 y0 = acc[ai][bj][m][0], y1 = acc[ai][bj][m][1];
                        const int d0 = 32 * bj + 8 * fq;
                        LAS bf16_t* p = T + d0 * 16 + pos;
                        const unsigned w0 = pk(y0[0], y0[1]), w1 = pk(y0[2], y0[3]), w2 = pk(y1[0], y1[1]), w3 = pk(y1[2], y1[3]);
                        p[0] = (bf16_t)w0; p[16] = (bf16_t)(w0 >> 16); p[32] = (bf16_t)w1; p[48] = (bf16_t)(w1 >> 16);
                        p[64] = (bf16_t)w2; p[80] = (bf16_t)(w2 >> 16); p[96] = (bf16_t)w3; p[112] = (bf16_t)(w3 >> 16);
                        if (u.pm < 32) { float* nv = newv + ((((size_t)u.pm * 2 + l) * 8 + hh) * 256 + rt) * 64 + d0; *(f32x4*)nv = y0; *(f32x4*)(nv + 4) = y1; }
                    }
                    {
                        const int lane = fq * 16 + fr, sidx = m & 1;
                        bf16_t* cbase = vtc + (((size_t)u.pm * 256 + wr * 64 + ai * 128 + m * 16) >> 5) * 8 * 2048 + (size_t)hh * 2048;
#pragma unroll
                        for (int k = 0; k < 2; ++k) {
                            const int pc = lane + 64 * k, dim = pc >> 1, hi = pc & 1;
                            const u32x4 w = *(const LAS u32x4*)(T + dim * 16 + hi * 8);
                            *(u32x4*)(cbase + ((((dim >> 5) * 2 + sidx) * 2 + hi) * 32 + (dim & 31)) * 8) = w;
                        }
                    }
                    __builtin_amdgcn_sched_barrier(0);
                }
        } else {
            const bool isg = pn >= 10;
            bf16_t* dst = isg ? gates : misc; const int ld = isg ? 3072 : 1024; const int cb = (isg ? pn - 10 : pn - 6) * 256 + wc * 32 + 8 * fq;
#pragma unroll
            for (int ai = 0; ai < 2; ++ai)
                if (u.amask & (1 << ai))
#pragma unroll
                for (int m = 0; m < 4; ++m) {
                    const size_t row = (size_t)u.pm * 256 + rt0 + ai * 128 + m * 16;
#pragma unroll
                    for (int bj = 0; bj < 2; ++bj) {
                        f32x4 y0 = acc[ai][bj][m][0], y1 = acc[ai][bj][m][1];
                        if (isg) {
#pragma unroll
                            for (int j = 0; j < 4; ++j) { y0[j] = fmaxf(sigm(y0[j]), 1e-9f); y1[j] = fmaxf(sigm(y1[j]), 1e-9f); }
                        }
                        u32x4 w; w.x = pk(y0[0], y0[1]); w.y = pk(y0[2], y0[3]); w.z = pk(y1[0], y1[1]); w.w = pk(y1[2], y1[3]);
                        *(u32x4*)(dst + row * ld + cb + bj * 128) = w;
                    }
                    __builtin_amdgcn_sched_barrier(0);
                }
        }
    }
};
struct EpiBr {
    static constexpr bool PERM = true, CHAIN = true;
    const bf16_t* gates; bf16_t* mg;
    DI void operator()(f32x4 (&acc)[2][2][4][2], const Unit& u, int wr, int wc, int fr, int fq) const {
        const int r0 = u.pm * 256 + wr * 64 + fr, col0 = u.pn * 256 + wc * 32 + 8 * fq;
        const bf16_t* gp = gates + (size_t)r0 * 3072 + u.mode * 1024 + col0;
        bf16_t* mp = mg + (size_t)r0 * 1024 + col0;
        const bool fin = u.mode == 2;
        u32x4 na[2], nb[2], da[2], db[2];
#define BR_LD(nd, dd, it) do { const size_t rr_ = (size_t)(((it) >> 2) * 128 + ((it) & 3) * 16); _Pragma("unroll") for (int bj = 0; bj < 2; ++bj) { nd[bj] = *(const u32x4*)(gp + rr_ * 3072 + bj * 128); \
            if (!fin) dd[bj] = *(const u32x4*)(gp + rr_ * 3072 + 1024 + bj * 128); else dd[bj] = (u32x4){0u, 0u, 0u, 0u}; } } while (0)
#define BR_RT(x, y) (fin ? (x) : (x) * __builtin_amdgcn_rcpf(y))
#define BR_ST(nd, dd, it) do { const size_t rr_ = (size_t)(((it) >> 2) * 128 + ((it) & 3) * 16); _Pragma("unroll") for (int bj = 0; bj < 2; ++bj) { \
            const u32x4 gn = nd[bj], gd = dd[bj]; f32x4& a0 = acc[(it) >> 2][bj][(it) & 3][0]; f32x4& a1 = acc[(it) >> 2][bj][(it) & 3][1]; \
            a0[0] *= BR_RT(bflo(gn.x), bflo(gd.x)); a0[1] *= BR_RT(bfhi(gn.x), bfhi(gd.x)); a0[2] *= BR_RT(bflo(gn.y), bflo(gd.y)); a0[3] *= BR_RT(bfhi(gn.y), bfhi(gd.y)); \
            a1[0] *= BR_RT(bflo(gn.z), bflo(gd.z)); a1[1] *= BR_RT(bfhi(gn.z), bfhi(gd.z)); a1[2] *= BR_RT(bflo(gn.w), bflo(gd.w)); a1[3] *= BR_RT(bfhi(gn.w), bfhi(gd.w)); \
            if (fin) { u32x4 w; w.x = pk(a0[0], a0[1]); w.y = pk(a0[2], a0[3]); w.z = pk(a1[0], a1[1]); w.w = pk(a1[2], a1[3]); *(u32x4*)(mp + rr_ * 1024 + bj * 128) = w; } } } while (0)
#pragma unroll
        for (int ai = 0; ai < 2; ++ai)
            if (u.amask & (1 << ai)) {
                BR_LD(na, da, ai * 4);
#pragma unroll
                for (int it = ai * 4; it < ai * 4 + 4; it += 2) {
                    BR_LD(nb, db, it + 1);
                    BR_ST(na, da, it);
                    __builtin_amdgcn_sched_barrier(0);
                    if (it + 2 < ai * 4 + 4) BR_LD(na, da, it + 2);
                    BR_ST(nb, db, it + 1);
                    __builtin_amdgcn_sched_barrier(0);
                }
            }
#undef BR_LD
#undef BR_RT
#undef BR_ST
    }
};

struct Params { const float* in[29]; float* out; unsigned char* ws; int ph_lo, ph_hi; };

DI void phase_mod(float* lds) {
    const int tid = otid();
    float* sc = lds;
    float* red = lds + 5120;
    for (int i = tid; i < 5120; i += 512) { const int v = i >> 10, k = i & 1023; const float x = v == 0 ? IN(5)[k] : IN(4)[(v - 1) * 1024 + k]; sc[i] = silu(x); }
    __syncthreads();
    float* mod = (float*)(WSP + WS_MOD);
    const int l16 = tid & 15, kg = tid >> 4;
    for (int item = blockIdx.x; item < 288; item += gridDim.x) {
        const int l = item / 144, n0 = (item % 144) * 64;
        const float* w = IN(6) + ((size_t)l * 1024 + kg * 32) * 9216 + n0 + 4 * l16;
        f32x4 a[5];
#pragma unroll
        for (int v = 0; v < 5; ++v) a[v] = (f32x4){0.f, 0.f, 0.f, 0.f};
#pragma unroll 8
        for (int kk = 0; kk < 32; ++kk) {
            const f32x4 wv = *(const f32x4*)(w + (size_t)kk * 9216);
#pragma unroll
            for (int v = 0; v < 5; ++v) a[v] += wv * sc[v * 1024 + kg * 32 + kk];
        }
#pragma unroll
        for (int v = 0; v < 5; ++v) *(f32x4*)(red + (kg * 5 + v) * 64 + 4 * l16) = a[v];
        __syncthreads();
        if (tid < 320) { const int v = tid >> 6, cc = tid & 63; float s = IN(7)[l * 9216 + n0 + cc];
            for (int q = 0; q < 32; ++q) s += red[(q * 5 + v) * 64 + cc];
            mod[(l * 5 + v) * 9216 + n0 + cc] = s; }
        __syncthreads();
    }
}
DI void phase_cache() {
    bf16_t* ck = (bf16_t*)(WSP + WS_CK); bf16_t* cvt = (bf16_t*)(WSP + WS_CVT);
    const int gt = blockIdx.x * 512 + otid(), ng = gridDim.x * 512;
    for (int i = gt; i < 262144; i += ng) {
        const int d0 = (i & 7) * 8, keyg = (i >> 3) & 511, blh = i >> 12, key = keyg & 31;
        const size_t cbase = ((size_t)blh * 16 + (keyg >> 5)) * 2048;
        const f32x4 k0 = *(const f32x4*)(IN(2) + (size_t)i * 8), k1 = *(const f32x4*)(IN(2) + (size_t)i * 8 + 4);
        u32x4 w; w.x = pk(k0[0], k0[1]); w.y = pk(k0[2], k0[3]); w.z = pk(k1[0], k1[1]); w.w = pk(k1[2], k1[3]);
        *(u32x4*)(ck + cbase + (((d0 >> 4) * 2 + ((d0 >> 3) & 1)) * 32 + key) * 8) = w;
        const f32x4 v0 = *(const f32x4*)(IN(3) + (size_t)i * 8), v1 = *(const f32x4*)(IN(3) + (size_t)i * 8 + 4);
        const int k16 = key & 15, grp = k16 >> 2;
        bf16_t* p = cvt + cbase + ((((d0 >> 5) * 2 + (key >> 4)) * 2 + (grp & 1)) * 32 + (d0 & 31)) * 8 + ((grp >> 1) * 4 + (k16 & 3));
        const unsigned w0 = pk(v0[0], v0[1]), w1 = pk(v0[2], v0[3]), w2 = pk(v1[0], v1[1]), w3 = pk(v1[2], v1[3]);
        p[0] = (bf16_t)w0; p[8] = (bf16_t)(w0 >> 16); p[16] = (bf16_t)w1; p[24] = (bf16_t)(w1 >> 16);
        p[32] = (bf16_t)w2; p[40] = (bf16_t)(w2 >> 16); p[48] = (bf16_t)w3; p[56] = (bf16_t)(w3 >> 16);
    }
}
template <int MAP> DI int rowmap(int j, int off) {
    if (MAP == 1) return 256 * (j >> 7) + off + (j & 127);
    if (MAP == 2) { if (j >= 1536) return j; const int t = j >> 8, w = j & 255; return 256 * t + 128 * ((w & 63) >> 5) + 32 * (w >> 6) + (w & 31); }
    return j;
}
template <int MAP, bool PANEL = false> DI void cvt_weight(const float* src, int K, int N, bf16_t* dst, int ldd, int koffd, int off, float* lds, int rank, int nr) {
    const int tid = otid(), ntn = N / 64, ntiles = (K / 64) * ntn, G = nr;
    for (int t0 = rank; t0 < ntiles; t0 += 4 * G) {
        float v[4][8];
#pragma unroll
        for (int q = 0; q < 4; ++q) { const int t = t0 + q * G; if (t < ntiles) { const int k0 = (t / ntn) * 64, j0 = (t % ntn) * 64;
#pragma unroll
            for (int i = 0; i < 8; ++i) v[q][i] = src[(size_t)(k0 + i * 8 + (tid >> 6)) * N + j0 + (tid & 63)]; } }
#pragma unroll
        for (int q = 0; q < 4; ++q) { const int t = t0 + q * G; if (t < ntiles) {
#pragma unroll
            for (int i = 0; i < 8; ++i) lds[q * 4160 + (i * 8 + (tid >> 6)) * 65 + (tid & 63)] = v[q][i]; } }
        __syncthreads();
#pragma unroll
        for (int q = 0; q < 4; ++q) { const int t = t0 + q * G; if (t < ntiles) { const int k0 = (t / ntn) * 64, j0 = (t % ntn) * 64;
            const int jj = tid >> 3, k8 = (tid & 7) * 8; float x[8];
#pragma unroll
            for (int e = 0; e < 8; ++e) x[e] = lds[q * 4160 + (k8 + e) * 65 + jj];
            u32x4 w; w.x = pk(x[0], x[1]); w.y = pk(x[2], x[3]); w.z = pk(x[4], x[5]); w.w = pk(x[6], x[7]);
            if (PANEL) *(u32x4*)(dst + ((size_t)(k0 >> 6) * N + (j0 + jj)) * 64 + k8) = w;
            else *(u32x4*)(dst + (size_t)rowmap<MAP>(j0 + jj, off) * ldd + koffd + k0 + k8) = w; } }
        __syncthreads();
    }
}
DI void phase_weights(int l, float* lds, int parts, int rank, int nr) {
    unsigned char* wb = WSP + WS_WB;
    if (parts & 1) { cvt_weight<1>(IN(9) + (size_t)l * 1024 * FF, 1024, FF, (bf16_t*)(wb + WB_GU1), 1024, 0, 0, lds, rank, nr);
                     cvt_weight<1>(IN(10) + (size_t)l * 1024 * FF, 1024, FF, (bf16_t*)(wb + WB_GU1), 1024, 0, 128, lds, rank, nr); }
    if (parts & 2) cvt_weight<0, true>(IN(11) + (size_t)l * FF * 1024, FF, 1024, (bf16_t*)(wb + WB_D1), FF, 0, 0, lds, rank, nr);
    if (parts & 4) cvt_weight<2>(IN(13) + (size_t)l * 1024 * INC, 1024, INC, (bf16_t*)(wb + WB_IN), 1024, 0, 0, lds, rank, nr);
    if (parts & 8) { cvt_weight<0>(IN(21) + (size_t)l * 512 * 1024, 512, 1024, (bf16_t*)(wb + WB_BR), 1024, 0, 0, lds, rank, nr);
                     cvt_weight<0>(IN(23) + (size_t)l * 256 * 1024, 256, 1024, (bf16_t*)(wb + WB_BR), 1024, 768, 0, lds, rank, nr); }
    if (parts & 16) cvt_weight<0>(IN(24) + (size_t)l * 1024 * 1024, 1024, 1024, (bf16_t*)(wb + WB_OUT), 1024, 0, 0, lds, rank, nr);
    if (parts & 32) { cvt_weight<1>(IN(26) + (size_t)l * 1024 * FF, 1024, FF, (bf16_t*)(wb + WB_GU2), 1024, 0, 0, lds, rank, nr);
                      cvt_weight<1>(IN(27) + (size_t)l * 1024 * FF, 1024, FF, (bf16_t*)(wb + WB_GU2), 1024, 0, 128, lds, rank, nr); }
    if (parts & 64) cvt_weight<0, true>(IN(28) + (size_t)l * FF * 1024, FF, 1024, (bf16_t*)(wb + WB_D2), FF, 0, 0, lds, rank, nr);
    if (parts & 8) {
        const float* wp = IN(17) + (size_t)l * 4 * 64 * 64; const float* ps = IN(18) + l * 256; const float* wbp = IN(22) + (size_t)l * 256 * 1024;
        bf16_t* br = (bf16_t*)(wb + WB_BR);
        for (int i = rank * 512 + otid(); i < 262144; i += nr * 512) {
            const int n = i & 1023, gc = i >> 10, g = gc >> 6;
            float s = 0.f;
            for (int d = 0; d < 64; ++d) s += wp[gc * 64 + d] * ps[g * 64 + d] * wbp[(size_t)(g * 64 + d) * 1024 + n];
            br[(size_t)n * 1024 + 512 + gc] = (bf16_t)pk(s, 0.f);
        }
    }
}
DI void phase_norm(const float* xc, const float* xl, bf16_t* hb, const float* g, const float* mod, int sidx) {
    const int tid = otid(), lane = tid & 63, gw = blockIdx.x * 8 + (tid >> 6), nw = gridDim.x * 8;
    for (int row0 = gw; row0 < TT; row0 += 4 * nw) {
        f32x4 v[4][4]; float ss[4];
#pragma unroll
        for (int q = 0; q < 4; ++q) { const int row = row0 + q * nw; ss[q] = 0.f;
            if (row < TT) { const float* xr = row < TC ? xc + (size_t)row * DM : xl + (size_t)(row - TC) * DM;
#pragma unroll
                for (int j = 0; j < 4; ++j) v[q][j] = *(const f32x4*)(xr + 4 * lane + 256 * j); } }
#pragma unroll
        for (int q = 0; q < 4; ++q) { const int row = row0 + q * nw;
            if (row < TT) {
#pragma unroll
                for (int j = 0; j < 4; ++j) ss[q] += (v[q][j][0] * v[q][j][0] + v[q][j][1] * v[q][j][1]) + (v[q][j][2] * v[q][j][2] + v[q][j][3] * v[q][j][3]);
#pragma unroll
                for (int o = 1; o < 64; o <<= 1) ss[q] += __shfl_xor(ss[q], o);
                const float r = rsqrtf(ss[q] * (1.0f / 1024.0f) + 1e-6f);
                const int bi = row < TC ? 0 : 1 + ((row - TC) >> 12);
                const float* sh = mod + (bi * NMOD + sidx) * DM; const float* sc = sh + DM;
#pragma unroll
                for (int j = 0; j < 4; ++j) {
                    const int c = 4 * lane + 256 * j;
                    const f32x4 gg = *(const f32x4*)(g + c), s1 = *(const f32x4*)(sc + c), s0 = *(const f32x4*)(sh + c);
                    const f32x4 y = v[q][j] * r * gg * (s1 + 1.0f) + s0;
                    u32x2 w; w.x = pk(y[0], y[1]); w.y = pk(y[2], y[3]);
                    *(u32x2*)(hb + (size_t)row * DM + c) = w;
                }
            } }
    }
}

struct AttnTask {
    const bf16_t* q;
    bf16_t* o;
    const bf16_t* kd; const bf16_t* vd; int dst; int nd;
    const bf16_t* kl; const bf16_t* vl; int nl;
    int r, rs, c, cs;
};
DI void attn_addr(const AttnTask& t, int ci, const bf16_t*& kp, const bf16_t*& vp) {
    if (ci < t.nd) { kp = t.kd + (size_t)ci * t.dst; vp = t.vd + (size_t)ci * t.dst; }
    else { const int li = ci - t.nd; const size_t off = (size_t)((t.rs + (li >> 1)) * 2 + (li & 1)) * 16384; kp = t.kl + off; vp = t.vl + off; }
}
DI void attn_load_k(const AttnTask& t, int ci, int lane, bf16x8 (&kf)[4]) {
    const bf16_t* kp; const bf16_t* vp; attn_addr(t, ci, kp, vp);
#pragma unroll
    for (int kk = 0; kk < 4; ++kk) kf[kk] = *(const bf16x8*)(kp + (kk * 64 + lane) * 8);
}
DI void attn_load_v(const AttnTask& t, int ci, int lane, bf16x8 (&vf)[4]) {
    const bf16_t* kp; const bf16_t* vp; attn_addr(t, ci, kp, vp);
#pragma unroll
    for (int f = 0; f < 4; ++f) vf[f] = *(const bf16x8*)(vp + (f * 64 + lane) * 8);
}
DI f32x16 attn_qk(const bf16x8 (&kf)[4], const bf16x8 (&qf)[4]) {
    f32x16 S;
#pragma unroll
    for (int i = 0; i < 16; ++i) S[i] = 0.f;
#pragma unroll
    for (int kk = 0; kk < 4; ++kk) S = __builtin_amdgcn_mfma_f32_32x32x16_bf16(kf[kk], qf[kk], S, 0, 0, 0);
    return S;
}
DI void attn_step(const AttnTask& t, const LAS float* rpb_lds, int ci, int hi, f32x16 S, const bf16x8 (&vf)[4], f32x16& O0, f32x16& O1, float& mrun, float& lrun) {
    if (ci >= t.nd) {
        const int li = ci - t.nd;
        const volatile LAS float* brow = rpb_lds + (t.rs + (li >> 1) - t.r + 7) * 31 - t.c + 15 + 32 * (li & 1) + 4 * hi;
        const int kc0 = 32 * (li & 1) + 4 * hi;
        float bias[16];
#pragma unroll
        for (int i = 0; i < 16; ++i) bias[i] = brow[8 * (i >> 2) + (i & 3)];
#pragma unroll
        for (int i = 0; i < 16; ++i) {
            const int kc = kc0 + 8 * (i >> 2) + (i & 3);
            const bool valid = (unsigned)(kc - t.cs) < 16u;
            const float sb = S[i] + bias[i];
            S[i] = valid ? sb : -1e30f;
        }
    }
    float mx = S[0];
#pragma unroll
    for (int i = 1; i < 16; ++i) mx = fmaxf(mx, S[i]);
    mx = xhalf_max(mx);
    if (__any(mx - mrun > 8.0f)) {
        const float mnew = fmaxf(mrun, mx), alpha = __builtin_amdgcn_exp2f(mrun - mnew);
        mrun = mnew; lrun *= alpha;
#pragma unroll
        for (int i = 0; i < 16; ++i) { O0[i] *= alpha; O1[i] *= alpha; }
    }
    float rs_ = 0.f;
#pragma unroll
    for (int i = 0; i < 16; ++i) { S[i] = __builtin_amdgcn_exp2f(S[i] - mrun); rs_ += S[i]; }
    lrun += rs_;
    bf16x8 pf[2];
#pragma unroll
    for (int s = 0; s < 2; ++s) {
        u32x4 w; w.x = pk(S[8 * s], S[8 * s + 1]); w.y = pk(S[8 * s + 2], S[8 * s + 3]); w.z = pk(S[8 * s + 4], S[8 * s + 5]); w.w = pk(S[8 * s + 6], S[8 * s + 7]);
        pf[s] = __builtin_bit_cast(bf16x8, w);
    }
#pragma unroll
    for (int s = 0; s < 2; ++s) { O0 = __builtin_amdgcn_mfma_f32_32x32x16_bf16(vf[s], pf[s], O0, 0, 0, 0); O1 = __builtin_amdgcn_mfma_f32_32x32x16_bf16(vf[2 + s], pf[s], O1, 0, 0, 0); }
}
DI void attn_task(const AttnTask& t, const LAS float* rpb_lds) {
    const int lane = otid() & 63, hi = lane >> 5;
    bf16x8 qf[4];
#pragma unroll
    for (int kk = 0; kk < 4; ++kk) qf[kk] = *(const bf16x8*)(t.q + 16 * kk + 8 * hi);
    f32x16 O0, O1;
#pragma unroll
    for (int i = 0; i < 16; ++i) { O0[i] = 0.f; O1[i] = 0.f; }
    float mrun = -1e30f, lrun = 0.f;
    const int nc = t.nd + t.nl;
    bf16x8 ka[4], kb[4], va[4], vb[4];
    attn_load_k(t, 0, lane, ka); attn_load_v(t, 0, lane, va); attn_load_k(t, 1, lane, kb);
    f32x16 Sa = attn_qk(ka, qf), Sb;
#pragma unroll 1
    for (int ci = 0; ci < nc; ci += 2) {
        attn_load_k(t, min(ci + 2, nc - 1), lane, ka); attn_load_v(t, ci + 1, lane, vb);
        Sb = attn_qk(kb, qf);
        attn_step(t, rpb_lds, ci, hi, Sa, va, O0, O1, mrun, lrun);
        attn_load_k(t, min(ci + 3, nc - 1), lane, kb); attn_load_v(t, min(ci + 2, nc - 1), lane, va);
        Sa = attn_qk(ka, qf);
        attn_step(t, rpb_lds, ci + 1, hi, Sb, vb, O0, O1, mrun, lrun);
    }
    lrun = xhalf_sum(lrun);
    const float inv = 1.0f / lrun;
#pragma unroll
    for (int g = 0; g < 4; ++g) {
        u32x2 w0, w1;
        w0.x = pk(O0[4 * g] * inv, O0[4 * g + 1] * inv); w0.y = pk(O0[4 * g + 2] * inv, O0[4 * g + 3] * inv);
        w1.x = pk(O1[4 * g] * inv, O1[4 * g + 1] * inv); w1.y = pk(O1[4 * g + 2] * inv, O1[4 * g + 3] * inv);
        *(u32x2*)(t.o + 8 * g + 4 * hi) = w0; *(u32x2*)(t.o + 32 + 8 * g + 4 * hi) = w1;
    }
}
DI void phase_mix(int l) {
    unsigned char* R = WSP + WS_R;
    const bf16_t* qb = (const bf16_t*)(R + R_Q); const bf16_t* kb = (const bf16_t*)(R + R_K); const bf16_t* vt = (const bf16_t*)(R + R_VT);
    const bf16_t* vtl = vt + (size_t)32 * 8 * 64 * 256;
    const bf16_t* misc = (const bf16_t*)(R + R_MISC);
    bf16_t* hb = (bf16_t*)(WSP + WS_HB);
    const bf16_t* ck = (const bf16_t*)(WSP + WS_CK); const bf16_t* cvt = (const bf16_t*)(WSP + WS_CVT);
    const int tid = otid(), lane = tid & 63, r31 = lane & 31, gw = blockIdx.x * 8 + (tid >> 6), nw = gridDim.x * 8;
    float* rl = (float*)shm;
    for (int i = tid; i < 3720; i += 512) rl[i] = IN(16)[l * 3720 + i] * 1.4426950408889634f;
    __syncthreads();
#pragma unroll 1
    for (int id = gw; id < 4096; id += nw) {
        const int qh = id & 1, r = (id >> 1) & 63, h = (id >> 7) & 7, b = id >> 10;
        const int t0 = TC + b * 4096 + r * 64 + 32 * qh;
        AttnTask t;
        t.q = qb + (size_t)(t0 + r31) * 512 + h * 64; t.o = hb + (size_t)(t0 + r31) * 1024 + h * 64;
        t.kd = ck + (size_t)((b * 2 + l) * 8 + h) * 16 * 2048; t.vd = cvt + (size_t)((b * 2 + l) * 8 + h) * 16 * 2048; t.dst = 2048; t.nd = 16;
        t.kl = kb + ((size_t)((TC + b * 4096) >> 5) * 8 + h) * 2048; t.vl = vt + ((size_t)((TC + b * 4096) >> 5) * 8 + h) * 2048; t.nl = 16;
        t.r = r; t.rs = min(max(r - 4, 0), 56); t.c = 32 * qh + r31; t.cs = min(max(t.c - 8, 0), 48);
        attn_task(t, (const LAS float*)shm + h * 465);
    }
#pragma unroll 1
    for (int id = gw; id < 2048; id += nw) {
        const int qbk = id & 7, h = (id >> 3) & 7, b = id >> 6;
        const int t0 = b * 256 + 32 * qbk;
        AttnTask t;
        t.q = qb + (size_t)(t0 + r31) * 512 + h * 64; t.o = hb + (size_t)(t0 + r31) * 1024 + h * 64;
        t.kd = kb + ((size_t)(b * 8) * 8 + h) * 2048; t.vd = vt + ((size_t)(b * 8) * 8 + h) * 2048; t.dst = 16384; t.nd = 8;
        t.kl = t.kd; t.vl = t.vd; t.nl = 0; t.r = 0; t.rs = 0; t.c = 0; t.cs = 0;
        attn_task(t, (const LAS float*)shm);
    }
}
DI void phase_poolconv(int l) {
    const bf16_t* misc = (const bf16_t*)(WSP + WS_R + R_MISC); bf16_t* hb = (bf16_t*)(WSP + WS_HB);
    const int tid = otid(), lane = tid & 63, gw = blockIdx.x * 8 + (tid >> 6), nw = gridDim.x * 8;
    const float* wcv = IN(19) + l * 768; const float* bcv = IN(20) + l * 256;
#pragma unroll 1
    for (int wi = gw; wi < (TT / 8) * 8; wi += nw) {
        const int g = wi & 7, tk = (wi >> 3) * 8 + (lane >> 3), ch = g * 64 + (lane & 7) * 8;
        int base, L; if (tk < TC) { base = tk & ~255; L = 256; } else { base = TC + ((tk - TC) & ~4095); L = 4096; }
        const int tl = tk - base;
        float o[8];
        if (g < 4) {
            const bf16_t* up = misc + (size_t)base * 1024 + ch;
            const u32x4 u = *(const u32x4*)(up + (size_t)tl * 1024);
            float s[8];
#pragma unroll
            for (int e = 0; e < 8; ++e) s[e] = 0.f;
            int cnt = 0;
#define POOL_W(W) do { _Pragma("unroll") for (int j = 0; j < W; ++j) { const int q = tl - W / 2 + j; const bool ok = q >= 0 && q < L; const int qq = min(max(q, 0), L - 1); \
                const u32x4 v = *(const u32x4*)(up + (size_t)qq * 1024); const float f = ok ? 1.0f : 0.0f; cnt += ok ? 1 : 0; \
                s[0] += f * bflo(v.x); s[1] += f * bfhi(v.x); s[2] += f * bflo(v.y); s[3] += f * bfhi(v.y); s[4] += f * bflo(v.z); s[5] += f * bfhi(v.z); s[6] += f * bflo(v.w); s[7] += f * bfhi(v.w); } } while (0)
            if (g == 0) POOL_W(2); else if (g == 1) POOL_W(4); else if (g == 2) POOL_W(8); else POOL_W(16);
#undef POOL_W
            const float inv = 1.0f / (float)cnt;
            o[0] = s[0] * inv - bflo(u.x); o[1] = s[1] * inv - bfhi(u.x); o[2] = s[2] * inv - bflo(u.y); o[3] = s[3] * inv - bfhi(u.y);
            o[4] = s[4] * inv - bflo(u.z); o[5] = s[5] * inv - bfhi(u.z); o[6] = s[6] * inv - bflo(u.w); o[7] = s[7] * inv - bfhi(u.w);
        } else {
            const int cc = ch - 256;
            const bf16_t* row0 = misc + (size_t)base * 1024;
            const u32x4 gb = *(const u32x4*)(row0 + (size_t)tl * 1024 + 512 + cc);
#pragma unroll
            for (int e = 0; e < 8; ++e) o[e] = bcv[cc + e];
#pragma unroll
            for (int j = 0; j < 3; ++j) {
                const int q = tl + j - 1; const bool ok = q >= 0 && q < L; const int qq = min(max(q, 0), L - 1); const float f = ok ? 1.0f : 0.0f;
                const bf16_t* row = row0 + (size_t)qq * 1024;
                const u32x4 uc = *(const u32x4*)(row + 256 + cc), gc = *(const u32x4*)(row + 768 + cc);
                const float* wj = wcv + j * 256 + cc;
                o[0] += f * wj[0] * bflo(uc.x) * bflo(gc.x); o[1] += f * wj[1] * bfhi(uc.x) * bfhi(gc.x); o[2] += f * wj[2] * bflo(uc.y) * bflo(gc.y); o[3] += f * wj[3] * bfhi(uc.y) * bfhi(gc.y);
                o[4] += f * wj[4] * bflo(uc.z) * bflo(gc.z); o[5] += f * wj[5] * bfhi(uc.z) * bfhi(gc.z); o[6] += f * wj[6] * bflo(uc.w) * bflo(gc.w); o[7] += f * wj[7] * bfhi(uc.w) * bfhi(gc.w);
            }
            o[0] *= bflo(gb.x); o[1] *= bfhi(gb.x); o[2] *= bflo(gb.y); o[3] *= bfhi(gb.y); o[4] *= bflo(gb.z); o[5] *= bfhi(gb.z); o[6] *= bflo(gb.w); o[7] *= bfhi(gb.w);
        }
        u32x4 w; w.x = pk(o[0], o[1]); w.y = pk(o[2], o[3]); w.z = pk(o[4], o[5]); w.w = pk(o[6], o[7]);
        *(u32x4*)(hb + (size_t)tk * 1024 + 512 + ch) = w;
    }
}

#define XB_TMO      128
#define XB_XCNT(j)  (256  + 64 * (j))
#define XB_XSUB(j)  (1280 + 64 * (j))
#define XB_XGEN(j)  (2304 + 64 * (j))
#define XB_TOP      3328
#define XB_TOPGEN   3392
#define XCD_BAR_WORDS 3456
#define XB_SPIN_CAP (1u << 22)
DI unsigned xb_ld(unsigned* p)              { return __hip_atomic_load(p, __ATOMIC_RELAXED, __HIP_MEMORY_SCOPE_AGENT); }
DI unsigned xb_add(unsigned* p, unsigned v) { return __hip_atomic_fetch_add(p, v, __ATOMIC_RELAXED, __HIP_MEMORY_SCOPE_AGENT); }
DI unsigned xb_xcc_id() { return (unsigned)__builtin_amdgcn_s_getreg((3 << 11) | 20) & 0xFu; }
#define XB_SPIN(cond, bar) do { unsigned _sp = 0; while (cond) { __builtin_amdgcn_s_sleep(1); \
    if ((++_sp & 255u) == 0u) { if (xb_ld(&(bar)[XB_TMO])) break; if (_sp > XB_SPIN_CAP) { atomicAdd(&(bar)[XB_TMO], 1u); break; } } } } while (0)
DI void xcd_barrier_complete(unsigned* bar, unsigned x, unsigned& nloc, unsigned& nx) {
    const unsigned G = gridDim.x;
    unsigned sum, cnt, mine, sp = 0u;
    for (;;) {
        sum = 0u; cnt = 0u; mine = 0u;
#pragma unroll
        for (unsigned j = 0; j < 16; ++j) { const unsigned c = xb_ld(&bar[XB_XCNT(j)]); sum += c; cnt += (c > 0u) ? 1u : 0u; mine = (j == x) ? c : mine; }
        if (sum == G) break;
        __builtin_amdgcn_s_sleep(1);
        if ((++sp & 255u) == 0u) { if (xb_ld(&bar[XB_TMO])) break; if (sp > XB_SPIN_CAP) { atomicAdd(&bar[XB_TMO], 1u); break; } }
    }
    nloc = mine > 0u ? mine : 1u; nx = cnt > 0u ? cnt : 1u;
}
DI void xcd_barrier() {
    asm volatile("s_waitcnt vmcnt(0)" ::: "memory");
    __syncthreads();
    if (threadIdx.x == 0) {
        unsigned* bar = (unsigned*)(WSP + WS_BAR);
        volatile LAS unsigned* st = (volatile LAS unsigned*)((LAS unsigned char*)shm + 131072 + 256);
        const unsigned x = xb_xcc_id();
        __builtin_amdgcn_s_waitcnt(0);
        unsigned nloc = st[0], nx = st[1];
        if (nloc == 0u) { xcd_barrier_complete(bar, x, nloc, nx); st[0] = nloc; st[1] = nx; }
        const unsigned old = xb_add(&bar[XB_XSUB(x)], 1u);
        const unsigned gen = old / nloc;
        if (old + 1u == (gen + 1u) * nloc) {
            __builtin_amdgcn_fence(__ATOMIC_RELEASE, "agent");
            asm volatile("s_waitcnt vmcnt(0)" ::: "memory");
            const unsigned og = xb_add(&bar[XB_TOP], 1u);
            const unsigned tg = og / nx;
            if (og + 1u == (tg + 1u) * nx) xb_add(&bar[XB_TOPGEN], 1u);
            else XB_SPIN(xb_ld(&bar[XB_TOPGEN]) == tg, bar);
            __builtin_amdgcn_fence(__ATOMIC_ACQUIRE, "agent");
            xb_add(&bar[XB_XGEN(x)], 1u);
            asm volatile("s_waitcnt vmcnt(0)" ::: "memory");
        } else {
            XB_SPIN(xb_ld(&bar[XB_XGEN(x)]) == gen, bar);
            __builtin_amdgcn_fence(__ATOMIC_ACQUIRE, "agent");
            asm volatile("s_waitcnt vmcnt(0)" ::: "memory");
        }
    }
    __syncthreads();
}

__global__ __launch_bounds__(512, 2) void mega(Params p) {
    cg::grid_group grid = cg::this_grid();
    if (threadIdx.x == 0) {
        LAS unsigned long long* tb = (LAS unsigned long long*)((LAS unsigned char*)shm + 131072);
#pragma unroll
        for (int i = 0; i < 29; ++i) tb[i] = (unsigned long long)p.in[i];
        tb[29] = (unsigned long long)p.out; tb[30] = (unsigned long long)p.ws;
        tb[32] = 0ull;
        (void)xb_add(&((unsigned*)(p.ws + WS_BAR))[XB_XCNT(xb_xcc_id())], 1u);
    }
    __syncthreads();
    const int ph_lo = p.ph_lo, ph_hi = p.ph_hi;
    for (int ph = ph_lo; ph < ph_hi; ++ph) {
        if (ph > ph_lo) { if (ph_hi > 4 * NPH) grid.sync(); else xcd_barrier(); if (REPMASK & 4096) xcd_barrier(); }
        LAS unsigned char* lds = (LAS unsigned char*)shm;
        float* ldsf = (float*)shm;
        if (ph == 0) { phase_mod(ldsf); phase_cache(); phase_weights(0, ldsf, gridDim.x == 256 ? 127 & ~64 : 127, blockIdx.x, gridDim.x); if (REPMASK & 2048) { __syncthreads(); phase_mod(ldsf); phase_cache(); phase_weights(0, ldsf, 127, blockIdx.x, gridDim.x); } continue; }
        const int l = (ph - 1) / 11, s = (ph - 1) % 11;
        unsigned char* ws = WSP; float* xo = OUTP;
        unsigned char* wb = ws + WS_WB; unsigned char* R = ws + WS_R;
        bf16_t* hb = (bf16_t*)(ws + WS_HB); bf16_t* act = (bf16_t*)(R); bf16_t* mg = (bf16_t*)(R + R_Q);
        const float* xoc = xo; const float* xol = xo + (size_t)TC * DM;
        const float* mod = (const float*)(ws + WS_MOD) + (size_t)l * 5 * 9216;
        Order S; Gemm g; g.ksa = 128; g.ksb = 128;
        const bool early = gridDim.x == 256;
        for (int rep = 0; rep < (((REPMASK >> s) & 1) ? 2 : 1); ++rep) {
        if (rep) __syncthreads();
        switch (s) {
        case 0: if (l > 0) phase_weights(l, ldsf, early ? 127 & ~(1 | 4 | 32 | 64) : 127, blockIdx.x, gridDim.x); phase_norm(l == 0 ? IN(0) : xoc, l == 0 ? IN(1) : xol, hb, IN(8) + l * DM, mod, 0); break;
        case 1: { S.init(96, 22, 16, 1); g.A = hb; g.Bt = (const bf16_t*)(wb + WB_GU1); g.lda = 1024; g.ldb = 1024; EpiSwiGLU E; E.O = act; gemm_phase(lds, g, S, E);
                  if (early && blockIdx.x >= 128) phase_weights(l, ldsf, l == 0 ? 64 : 32, blockIdx.x - 128, 128); } break;
        case 2: { S.init(96, 4, 44, 1); g.A = act; g.Bt = (const bf16_t*)(wb + WB_D1); g.lda = 64; g.ldb = 64; g.ksa = (size_t)TT * 128; g.ksb = (size_t)1024 * 128; EpiResid E; E.xin_c = l == 0 ? IN(0) : xoc; E.xin_l = l == 0 ? IN(1) : xol; E.xout = xo; E.mod = mod; E.gidx = 2; E.gs = 0.5f; gemm_phase(lds, g, S, E); } break;
        case 3: phase_norm(xoc, xol, hb, IN(12) + l * DM, mod, 3); break;
        case 4: { S.init(96, 22, 16, 1); g.A = hb; g.Bt = (const bf16_t*)(wb + WB_IN); g.lda = 1024; g.ldb = 1024; EpiIn E;
                  E.qb = (bf16_t*)(R + R_Q); E.kb = (bf16_t*)(R + R_K); E.vtc = (bf16_t*)(R + R_VT); E.vtl = E.vtc + (size_t)32 * 8 * 64 * 256; E.misc = (bf16_t*)(R + R_MISC); E.gates = (bf16_t*)(R + R_GATES);
                  E.newk = xo + OUT_NEWK; E.newv = xo + OUT_NEWV; E.gq = IN(14) + l * 64; E.gk = IN(15) + l * 64; E.l = l; gemm_phase(lds, g, S, E);
                  if (early && blockIdx.x >= 128) phase_weights(1, ldsf, l == 0 ? 1 : 64, blockIdx.x - 128, 128); } break;
        case 5: phase_mix(l); if (REPMASK & 8192) { __syncthreads(); phase_mix(l); } phase_poolconv(l); if (REPMASK & 16384) phase_poolconv(l); break;
        case 6: { S.init(96, 4, 0, 3); g.A = hb; g.Bt = (const bf16_t*)(wb + WB_BR); g.lda = 1024; g.ldb = 1024; EpiBr E; E.gates = (const bf16_t*)(R + R_GATES); E.mg = mg; gemm_phase(lds, g, S, E); } break;
        case 7: { S.init(96, 4, 16, 1); g.A = mg; g.Bt = (const bf16_t*)(wb + WB_OUT); g.lda = 1024; g.ldb = 1024; EpiResid E; E.xin_c = xoc; E.xin_l = xol; E.xout = xo; E.mod = mod; E.gidx = 5; E.gs = 1.0f; gemm_phase(lds, g, S, E); } break;
        case 8: phase_norm(xoc, xol, hb, IN(25) + l * DM, mod, 6); break;
        case 9: { S.init(96, 22, 16, 1); g.A = hb; g.Bt = (const bf16_t*)(wb + WB_GU2); g.lda = 1024; g.ldb = 1024; EpiSwiGLU E; E.O = act; gemm_phase(lds, g, S, E);
                  if (early && l == 0 && blockIdx.x >= 128) phase_weights(1, ldsf, 4, blockIdx.x - 128, 128); } break;
        case 10: { S.init(96, 4, 44, 1); g.A = act; g.Bt = (const bf16_t*)(wb + WB_D2); g.lda = 64; g.ldb = 64; g.ksa = (size_t)TT * 128; g.ksb = (size_t)1024 * 128; EpiResid E; E.xin_c = xoc; E.xin_l = xol; E.xout = xo; E.mod = mod; E.gidx = 8; E.gs = 0.5f; gemm_phase(lds, g, S, E); } break;
        }
        }
    }
}

extern "C" void kernel_launch(void* const* d_in, const int* in_sizes, int n_in, void* d_out, int out_size, void* d_ws, size_t ws_size, hipStream_t stream) {
    static int grid = 0;
    if (grid == 0) {
        if (n_in != 29 || ws_size < WS_END) { fprintf(stderr, "kernel_launch: bad n_in %d or ws %zu < %zu\n", n_in, ws_size, (size_t)WS_END); grid = -1; return; }
        int dev = 0, cus = 0, per_cu = 0;
        hipGetDevice(&dev); hipDeviceGetAttribute(&cus, hipDeviceAttributeMultiprocessorCount, dev);
        if (hipFuncSetAttribute((const void*)mega, hipFuncAttributeMaxDynamicSharedMemorySize, LDS_BYTES) != hipSuccess) { fprintf(stderr, "hipFuncSetAttribute failed\n"); grid = -1; return; }
        hipOccupancyMaxActiveBlocksPerMultiprocessor(&per_cu, (const void*)mega, 512, LDS_BYTES);
        (void)hipGetLastError();
        if (per_cu < 1) per_cu = 1;
        grid = cus * per_cu;
    }
    if (grid < 0) return;
    if (hipMemsetAsync((char*)d_ws + WS_BAR, 0, 16384, stream) != hipSuccess) { fprintf(stderr, "memset failed\n"); return; }
    Params p{};
    for (int i = 0; i < 29; ++i) p.in[i] = (const float*)d_in[i];
    p.out = (float*)d_out; p.ws = (unsigned char*)d_ws; p.ph_lo = 0; p.ph_hi = PHI;
    void* args[] = {&p};
    hipError_t e = hipLaunchCooperativeKernel((const void*)mega, dim3(grid), dim3(512), args, LDS_BYTES, stream);
    if (e != hipSuccess) fprintf(stderr, "cooperative launch failed: %s (grid %d)\n", hipGetErrorString(e), grid);
}
```
